# Optimizing an MI355X kernel written in HIP

```python
import math
import jax
import jax.numpy as jnp
from jax import lax
import numpy as np

D_MODEL = 1024
BATCH = 4
SEQ = 8192
DEPTH = 4
DEC_BATCH = 16
DEC_SEQ = 4096
PAST_LEN = 128

POOL_GROUPS = 4
POOL_GROUP_WIDTH = D_MODEL // 8
POOL_WIDTH = POOL_GROUPS * POOL_GROUP_WIDTH
POOL_WINDOWS = (2, 4, 8, 16)
DA_HEADS = 8
DA_HEAD_DIM = 64
DA_V_DIM = 2 * DA_HEAD_DIM
DA_WIDTH = DA_HEADS * DA_V_DIM
DA_QK_WIDTH = DA_HEADS * 2 * DA_HEAD_DIM
ROT_DIM = DA_HEAD_DIM // 4
ROPE_THETA = 500000.0
QBLOCK = 128
SUBLN_EPS = 1e-5
N_MEM = 256
XA_HEADS = 4
XA_HEAD_DIM = 128
XA_WIDTH = XA_HEADS * XA_HEAD_DIM
N_BRANCHES = 3
LN_EPS = 1e-5
IN_SPLITS = (POOL_WIDTH, POOL_WIDTH, DA_QK_WIDTH, DA_QK_WIDTH, DA_WIDTH, DA_WIDTH,
             XA_WIDTH, XA_WIDTH, N_BRANCHES * D_MODEL)
IN_COLS = sum(IN_SPLITS)
SPLIT_POINTS = [sum(IN_SPLITS[:i + 1]) for i in range(len(IN_SPLITS) - 1)]
DEEPNORM_ALPHA = (2.0 * DEPTH) ** 0.25
DEEPNORM_BETA = (8.0 * DEPTH) ** -0.25

kernel_name = "hybrid_pool_diffattn_memxattn_encoder"


def _layernorm(x, g, b):
    xf = x.astype(jnp.float32)
    mu = jnp.mean(xf, axis=-1, keepdims=True)
    var = jnp.mean(jnp.square(xf - mu), axis=-1, keepdims=True)
    y = (xf - mu) * lax.rsqrt(var + LN_EPS) * g.astype(jnp.float32) + b.astype(jnp.float32)
    return y.astype(x.dtype)


def _rope_tables(seq):
    pos = jnp.arange(seq, dtype=jnp.float32)
    inv = ROPE_THETA ** (-jnp.arange(0, ROT_DIM, 2, dtype=jnp.float32) / ROT_DIM)
    ang = pos[:, None] * inv[None, :]
    return jnp.cos(ang), jnp.sin(ang)


def _apply_partial_rope(x, cos, sin):
    half = ROT_DIM // 2
    c = cos[None, :, None, None, :].astype(x.dtype)
    s = sin[None, :, None, None, :].astype(x.dtype)
    x1 = x[..., :half]
    x2 = x[..., half:ROT_DIM]
    rot = jnp.concatenate([x1 * c - x2 * s, x2 * c + x1 * s], axis=-1)
    return jnp.concatenate([rot, x[..., ROT_DIM:]], axis=-1)


def _pool_mixer(u, pool_w, pool_scale):
    B, S, _ = u.shape
    uf = u.astype(jnp.float32)
    cs = jnp.concatenate([jnp.zeros((B, 1, POOL_WIDTH), jnp.float32), jnp.cumsum(uf, axis=1)], axis=1)
    t = jnp.arange(S)
    outs = []
    for g, w in enumerate(POOL_WINDOWS):
        lo = jnp.maximum(t - w // 2, 0)
        hi = jnp.minimum(t + w // 2 - 1, S - 1)
        csg = cs[..., g * POOL_GROUP_WIDTH:(g + 1) * POOL_GROUP_WIDTH]
        wsum = jnp.take(csg, hi + 1, axis=1) - jnp.take(csg, lo, axis=1)
        cnt = (hi - lo + 1).astype(jnp.float32)[None, :, None]
        outs.append(wsum / cnt)
    pooled = jnp.stack(outs, axis=2)
    d = (pooled - uf.reshape(B, S, POOL_GROUPS, POOL_GROUP_WIDTH)).astype(u.dtype)
    y = jnp.einsum('bsgc,gcd->bsgd', d, pool_w)
    return y.reshape(B, S, POOL_WIDTH) * pool_scale


def _diff_attention(q, k, v, lam, lam_init, subln_g):
    B, S, H, _, DH = q.shape
    nb = S // QBLOCK
    qb = q.reshape(B, nb, QBLOCK, H, 2, DH).transpose(1, 0, 2, 3, 4, 5)
    scale = DH ** -0.5

    def one_block(qblk):
        s = jnp.einsum('bqhcd,bkhcd->bhcqk', qblk, k).astype(jnp.float32) * scale
        p = jax.nn.softmax(s, axis=-1)
        a = p[:, :, 0] - lam * p[:, :, 1]
        return jnp.einsum('bhqk,bkhe->bqhe', a.astype(v.dtype), v)

    o = lax.map(one_block, qb)
    o = o.transpose(1, 0, 2, 3, 4).reshape(B, S, H, DA_V_DIM)
    of = o.astype(jnp.float32)
    of = of * lax.rsqrt(jnp.mean(jnp.square(of), axis=-1, keepdims=True) + SUBLN_EPS)
    of = of * subln_g.astype(jnp.float32) * (1.0 - lam_init)
    return of.astype(v.dtype)


def _layer(x, mem, cos, sin, lam_init, w_in, w_mem_kv, pool_w, pool_scale,
           lam_q1, lam_k1, lam_q2, lam_k2, subln_g, w_br_a, w_br_b, w_br_c, w_out, ln_g, ln_b):
    B, S, _ = x.shape
    h = jnp.einsum('bsd,de->bse', x, w_in)
    pu, pz, q, k, v, az, xq, xz, gl = jnp.split(h, SPLIT_POINTS, axis=-1)

    ya = _pool_mixer(pu, pool_w, pool_scale) * jax.nn.silu(pz)
    ya = jnp.einsum('bsc,cd->bsd', ya, w_br_a)

    q = _apply_partial_rope(q.reshape(B, S, DA_HEADS, 2, DA_HEAD_DIM), cos, sin)
    k = _apply_partial_rope(k.reshape(B, S, DA_HEADS, 2, DA_HEAD_DIM), cos, sin)
    v = v.reshape(B, S, DA_HEADS, DA_V_DIM)
    lam = (jnp.exp(jnp.sum(lam_q1.astype(jnp.float32) * lam_k1.astype(jnp.float32)))
           - jnp.exp(jnp.sum(lam_q2.astype(jnp.float32) * lam_k2.astype(jnp.float32)))
           + lam_init)
    yb = _diff_attention(q, k, v, lam, lam_init, subln_g).reshape(B, S, DA_WIDTH) * jax.nn.silu(az)
    yb = jnp.einsum('bsc,cd->bsd', yb, w_br_b)

    kv = jnp.einsum('bmd,de->bme', mem, w_mem_kv)
    km, vm = jnp.split(kv, 2, axis=-1)
    km = km.reshape(B, N_MEM, XA_HEADS, XA_HEAD_DIM)
    vm = vm.reshape(B, N_MEM, XA_HEADS, XA_HEAD_DIM)
    xq = xq.reshape(B, S, XA_HEADS, XA_HEAD_DIM)
    sc = jnp.einsum('bshd,bmhd->bhsm', xq, km).astype(jnp.float32) * (XA_HEAD_DIM ** -0.5)
    pm = jax.nn.softmax(sc, axis=-1).astype(vm.dtype)
    yc = jnp.einsum('bhsm,bmhd->bshd', pm, vm).reshape(B, S, XA_WIDTH) * jax.nn.silu(xz)
    yc = jnp.einsum('bsc,cd->bsd', yc, w_br_c)

    g = jax.nn.sigmoid(gl).reshape(B, S, N_BRANCHES, D_MODEL)
    merged = g[:, :, 0] * ya + g[:, :, 1] * yb + g[:, :, 2] * yc
    out = jnp.einsum('bsd,de->bse', merged, w_out)
    return _layernorm(DEEPNORM_ALPHA * x + out, ln_g, ln_b)


def _trunk(x, mem, ln_in_g, ln_in_b, w_in, w_mem_kv, pool_w, pool_scale,
           lam_q1, lam_k1, lam_q2, lam_k2, subln_g, w_br_a, w_br_b, w_br_c, w_out, ln_g, ln_b):
    cos, sin = _rope_tables(x.shape[1])
    x = _layernorm(x, ln_in_g, ln_in_b)
    for i in range(DEPTH):
        lam_init = 0.8 - 0.6 * math.exp(-0.3 * i)
        x = _layer(x, mem, cos, sin, lam_init, w_in[i], w_mem_kv[i], pool_w[i], pool_scale[i],
                   lam_q1[i], lam_k1[i], lam_q2[i], lam_k2[i], subln_g[i],
                   w_br_a[i], w_br_b[i], w_br_c[i], w_out[i], ln_g[i], ln_b[i])
    return x


def setup_inputs(seed: int = 0) -> dict:
    key = jax.random.key(seed)
    ks = jax.random.split(key, 24)
    f32 = jnp.float32
    x_prompt = jax.random.normal(ks[0], (BATCH, SEQ, D_MODEL), f32)
    x_sample = jax.random.normal(ks[1], (DEC_BATCH, DEC_SEQ, D_MODEL), f32)
    mem_prompt = jax.random.normal(ks[2], (BATCH, N_MEM, D_MODEL), f32)
    mem_sample = jax.random.normal(ks[3], (DEC_BATCH, N_MEM, D_MODEL), f32)
    ln_in_g = 1.0 + 0.02 * jax.random.normal(ks[4], (D_MODEL,), f32)
    ln_in_b = 0.02 * jax.random.normal(ks[5], (D_MODEL,), f32)
    col_scale = jnp.concatenate([
        jnp.ones((sum(IN_SPLITS[:4]),), f32),
        jnp.full((DA_WIDTH,), DEEPNORM_BETA, f32),
        jnp.ones((sum(IN_SPLITS[5:]),), f32)])
    w_in = jax.random.normal(ks[6], (DEPTH, D_MODEL, IN_COLS), f32) * (D_MODEL ** -0.5) * col_scale
    mem_scale = jnp.concatenate([jnp.ones((XA_WIDTH,), f32), jnp.full((XA_WIDTH,), DEEPNORM_BETA, f32)])
    w_mem_kv = jax.random.normal(ks[7], (DEPTH, D_MODEL, 2 * XA_WIDTH), f32) * (D_MODEL ** -0.5) * mem_scale
    pool_w = jax.random.normal(ks[8], (DEPTH, POOL_GROUPS, POOL_GROUP_WIDTH, POOL_GROUP_WIDTH), f32) * (POOL_GROUP_WIDTH ** -0.5)
    pool_scale = 1.0 + 0.1 * jax.random.normal(ks[9], (DEPTH, POOL_WIDTH), f32)
    lam_q1 = 0.1 * jax.random.normal(ks[10], (DEPTH, DA_HEAD_DIM), f32)
    lam_k1 = 0.1 * jax.random.normal(ks[11], (DEPTH, DA_HEAD_DIM), f32)
    lam_q2 = 0.1 * jax.random.normal(ks[12], (DEPTH, DA_HEAD_DIM), f32)
    lam_k2 = 0.1 * jax.random.normal(ks[13], (DEPTH, DA_HEAD_DIM), f32)
    subln_g = 1.0 + 0.02 * jax.random.normal(ks[14], (DEPTH, DA_V_DIM), f32)
    w_br_a = jax.random.normal(ks[15], (DEPTH, POOL_WIDTH, D_MODEL), f32) * (POOL_WIDTH ** -0.5) * DEEPNORM_BETA
    w_br_b = jax.random.normal(ks[16], (DEPTH, DA_WIDTH, D_MODEL), f32) * (DA_WIDTH ** -0.5) * DEEPNORM_BETA
    w_br_c = jax.random.normal(ks[17], (DEPTH, XA_WIDTH, D_MODEL), f32) * (XA_WIDTH ** -0.5) * DEEPNORM_BETA
    w_out = jax.random.normal(ks[18], (DEPTH, D_MODEL, D_MODEL), f32) * (D_MODEL ** -0.5) * DEEPNORM_BETA
    ln_g = 1.0 + 0.02 * jax.random.normal(ks[19], (DEPTH, D_MODEL), f32)
    ln_b = 0.02 * jax.random.normal(ks[20], (DEPTH, D_MODEL), f32)
    return {"x_prompt": x_prompt, "x_sample": x_sample, "mem_prompt": mem_prompt, "mem_sample": mem_sample,
            "ln_in_g": ln_in_g, "ln_in_b": ln_in_b, "w_in": w_in, "w_mem_kv": w_mem_kv,
            "pool_w": pool_w, "pool_scale": pool_scale, "lam_q1": lam_q1, "lam_k1": lam_k1,
            "lam_q2": lam_q2, "lam_k2": lam_k2, "subln_g": subln_g, "w_br_a": w_br_a,
            "w_br_b": w_br_b, "w_br_c": w_br_c, "w_out": w_out, "ln_g": ln_g, "ln_b": ln_b}


def reference(x_prompt, x_sample, mem_prompt, mem_sample, ln_in_g, ln_in_b, w_in, w_mem_kv,
              pool_w, pool_scale, lam_q1, lam_k1, lam_q2, lam_k2, subln_g, w_br_a, w_br_b,
              w_br_c, w_out, ln_g, ln_b):
    y_prompt = _trunk(x_prompt, mem_prompt, ln_in_g, ln_in_b, w_in, w_mem_kv, pool_w, pool_scale,
                      lam_q1, lam_k1, lam_q2, lam_k2, subln_g, w_br_a, w_br_b, w_br_c, w_out, ln_g, ln_b)
    y_sample = _trunk(x_sample, mem_sample, ln_in_g, ln_in_b, w_in, w_mem_kv, pool_w, pool_scale,
                      lam_q1, lam_k1, lam_q2, lam_k2, subln_g, w_br_a, w_br_b, w_br_c, w_out, ln_g, ln_b)
    return (y_prompt, y_sample)
```

```cpp
#include <hip/hip_runtime.h>
#include <hip/hip_cooperative_groups.h>
#include <cstdio>
#include <cstdint>
namespace cg = cooperative_groups;
#define PROBE_ATT2 0
#define PROBE_P1X2 0
#define PROBE_SYNC 0

constexpr int DM = 1024, DEPTH = 4, INC = 9216;
constexpr int NP = 32768, NTOK = 98304;
constexpr int SP = 8192, SS = 4096;
constexpr int C_PZ = 512, C_Q = 1024, C_K = 2048, C_V = 3072, C_AZ = 4096, C_XQ = 5120, C_XZ = 5632, C_GL = 6144;
constexpr int MEMROWS = 20 * 256;
constexpr float ALPHA = 1.681792830507429f;
constexpr float LN_EPS = 1e-5f, SUBLN_EPS = 1e-5f;
constexpr int NWAVES = 8;

typedef unsigned short bf16_t;
typedef short bf16x8 __attribute__((ext_vector_type(8)));
typedef short s16x4 __attribute__((ext_vector_type(4)));
typedef float f32x4 __attribute__((ext_vector_type(4)));
typedef float f32x8 __attribute__((ext_vector_type(8)));
typedef float f32x16 __attribute__((ext_vector_type(16)));
typedef unsigned u32x4 __attribute__((ext_vector_type(4)));
typedef unsigned u32x2 __attribute__((ext_vector_type(2)));

constexpr size_t MiB = 1u << 20;
constexpr size_t WS_CTL = 0;
constexpr size_t WS_ROPE = 4096;
constexpr size_t WS_BAR = 768 * 1024, BAR_BYTES = 16384;
constexpr size_t WS_WIN = 1 * MiB;
constexpr size_t WS_WMEM = 73 * MiB;
constexpr size_t WS_WBA = 81 * MiB;
constexpr size_t WS_WBB = 85 * MiB;
constexpr size_t WS_WBC = 93 * MiB;
constexpr size_t WS_WOUT = 97 * MiB;
constexpr size_t WS_MEMB = 105 * MiB;
constexpr size_t WS_KVM = 115 * MiB;
constexpr size_t WS_XB = 155 * MiB;
constexpr size_t WS_H = 347 * MiB;

__device__ __forceinline__ unsigned cvt_pk_bf16(float lo, float hi) { unsigned r; asm volatile("v_cvt_pk_bf16_f32 %0, %1, %2" : "=v"(r) : "v"(lo), "v"(hi)); return r; }
__device__ __forceinline__ float bf_lo(unsigned u) { return __uint_as_float(u << 16); }
__device__ __forceinline__ float bf_hi(unsigned u) { return __uint_as_float(u & 0xffff0000u); }
__device__ __forceinline__ float bf2f(bf16_t v) { return __uint_as_float(((unsigned)v) << 16); }
__device__ __forceinline__ int opaque_tid() { int t = threadIdx.x; asm volatile("" : "+v"(t)); return t; }
__device__ __forceinline__ float sigmoidf_(float x) { return __builtin_amdgcn_rcpf(1.f + __expf(-x)); }

namespace pg8 {
#define PG8_LAS __attribute__((address_space(3)))
constexpr int BM = 256, BK = 64, HALF = 128, HTB = HALF * BK * 2, STAGE_BYTES = 8 * HTB, NXCD = 8, WGM = 8;

__host__ __device__ __forceinline__ int lds_byte(int r, int c) { const int st = (r >> 4) * 2 + (c >> 5), rr = r & 15, cc = c & 31, ob = rr * 64 + cc * 2; return st * 1024 + (ob ^ (((ob >> 9) & 1) << 5)); }
__host__ __device__ __forceinline__ void stage_rc(int b, int& R, int& C) { const int st = b / 1024, sb = b % 1024, swz = sb ^ (((sb >> 9) & 1) << 5); R = (st >> 1) * 16 + swz / 64; C = (st & 1) * 32 + (swz % 64) / 2; }
__host__ __device__ __forceinline__ int perm32(int rho) { const int n = rho >> 4, i = rho & 15; return 8 * (i >> 2) + 4 * n + (i & 3); }

struct Unit { int pm, pn, br; };
struct Gemm { const bf16_t* A; const bf16_t* Bt; int M, N, K, lda, ldb; };

struct StaticOrder {
    int nM, nN, nwg, G, c;
    __host__ __device__ void init(int M, int N, int G_, int c_) { nM = M / BM; nN = N / BM; nwg = nM * nN; G = G_; c = c_; }
    __host__ __device__ bool next(int i, Unit& u) const {
        const long L = (long)i * G + c; if (L >= nwg) return false;
        int wgid = (int)L; { const int q = nwg / NXCD, r = nwg % NXCD, xcd = wgid % NXCD, off = wgid / NXCD; wgid = (xcd < r ? xcd * (q + 1) : r * (q + 1) + (xcd - r) * q) + off; }
        const int nig = WGM * nN, gid = wgid / nig, fm = gid * WGM, gsz = (nM - fm) < WGM ? (nM - fm) : WGM;
        u.pm = fm + ((wgid % nig) % gsz); u.pn = (wgid % nig) / gsz; u.br = 0; return true;
    }
};
struct Order3 { StaticOrder base;
    __host__ __device__ bool next(int i, Unit& u) const { if (!base.next(i / 3, u)) return false; u.br = i % 3; return true; } };
#define PG8_EPI_DEFAULTS static constexpr bool SELFZERO = false; \
    __device__ static __forceinline__ size_t aoff(const Unit&) { return 0; } \
    __device__ static __forceinline__ size_t boff(const Unit&) { return 0; } \
    __device__ static __forceinline__ int nt(const Unit&, int ntdef) { return ntdef; }


struct EpiStore {
    static constexpr bool PERM = true; PG8_EPI_DEFAULTS
    bf16_t* O; int ldc;
    __device__ __forceinline__ void operator()(const f32x4 (&acc)[2][2][4][2], const Unit& u, int wr, int wc, int fr, int fq) const {
        const int row0 = u.pm * BM + wr * 64 + fr, col0 = u.pn * BM + wc * 32 + 8 * fq;
#pragma unroll
        for (int ai = 0; ai < 2; ++ai)
#pragma unroll
            for (int m = 0; m < 4; ++m) { bf16_t* rowp = O + (size_t)(row0 + ai * HALF + m * 16) * ldc + col0;
#pragma unroll
                for (int bj = 0; bj < 2; ++bj) { const f32x4 v0 = acc[ai][bj][m][0], v1 = acc[ai][bj][m][1];
                    u32x4 w; w.x = cvt_pk_bf16(v0[0], v0[1]); w.y = cvt_pk_bf16(v0[2], v0[3]); w.z = cvt_pk_bf16(v1[0], v1[1]); w.w = cvt_pk_bf16(v1[2], v1[3]);
                    *(u32x4*)(rowp + bj * HALF) = w; } }
    }
};
struct EpiIn {
    static constexpr bool PERM = true; PG8_EPI_DEFAULTS
    bf16_t* H; const float* rope; int row0g, smask;
    __device__ __forceinline__ void operator()(const f32x4 (&acc)[2][2][4][2], const Unit& u, int wr, int wc, int fr, int fq) const {
        const int row0 = u.pm * BM + wr * 64 + fr, colt = u.pn * BM, col0 = colt + wc * 32 + 8 * fq;
        const bool ropewave = (colt >= C_Q && colt < C_V) && ((wc & 1) == 0);
        const float qs = (colt >= C_Q && colt < C_K) ? 0.125f * 1.4426950408889634f : (colt >= C_XQ && colt < C_XZ) ? 0.088388347648318440f * 1.4426950408889634f : 1.f;
#pragma unroll
        for (int ai = 0; ai < 2; ++ai)
#pragma unroll
            for (int m = 0; m < 4; ++m) { const int row = row0 + ai * HALF + m * 16; bf16_t* rowp = H + (size_t)row * INC + col0;
                f32x4 c0 = {1.f, 1.f, 1.f, 1.f}, c1 = c0, s0 = {0.f, 0.f, 0.f, 0.f}, s1 = s0;
                if (ropewave && fq < 2) { const float* rp = rope + (size_t)((row0g + row) & smask) * 16;
                    c0 = *(const f32x4*)rp; c1 = *(const f32x4*)(rp + 4); s0 = *(const f32x4*)(rp + 8); s1 = *(const f32x4*)(rp + 12);
                    if (fq == 0) { s0 = -s0; s1 = -s1; } }
#pragma unroll
                for (int bj = 0; bj < 2; ++bj) { f32x4 v0 = acc[ai][bj][m][0], v1 = acc[ai][bj][m][1];
                    if (ropewave) { f32x4 p0, p1;
#pragma unroll
                        for (int e = 0; e < 4; ++e) { p0[e] = __shfl_xor(v0[e], 16); p1[e] = __shfl_xor(v1[e], 16); }
                        v0 = v0 * c0 + p0 * s0; v1 = v1 * c1 + p1 * s1; }
                    v0 = v0 * qs; v1 = v1 * qs;
                    if (colt >= C_GL) {
#pragma unroll
                        for (int e = 0; e < 4; ++e) { v0[e] = sigmoidf_(fmaxf(v0[e], -30.f)); v1[e] = sigmoidf_(fmaxf(v1[e], -30.f)); } }
                    u32x4 w; w.x = cvt_pk_bf16(v0[0], v0[1]); w.y = cvt_pk_bf16(v0[2], v0[3]); w.z = cvt_pk_bf16(v1[0], v1[1]); w.w = cvt_pk_bf16(v1[2], v1[3]);
                    *(u32x4*)(rowp + bj * HALF) = w; } }
    }
};
__device__ __forceinline__ float gclamp(float x) { return fminf(fmaxf(x, -30.f), 30.f); }
struct EpiBr3 {
    static constexpr bool PERM = true, SELFZERO = true;
    bf16_t* H;
    __device__ static __forceinline__ size_t aoff(const Unit& u) { return (size_t)(u.br == 0 ? C_PZ : u.br == 1 ? C_Q : C_XQ) * 2; }
    __device__ static __forceinline__ size_t boff(const Unit& u) { return (size_t)(u.br == 0 ? 0 : u.br == 1 ? 512 : 1536) * 2; }
    __device__ static __forceinline__ int nt(const Unit& u, int) { return u.br == 1 ? 16 : 8; }
    __device__ __forceinline__ void operator()(f32x4 (&acc)[2][2][4][2], const Unit& u, int wr, int wc, int fr, int fq) const {
        const int row0 = u.pm * BM + wr * 64 + fr, col0 = u.pn * BM + wc * 32 + 8 * fq;
        const int br = u.br;
#pragma unroll
        for (int ai = 0; ai < 2; ++ai)
#pragma unroll
            for (int m = 0; m < 4; ++m) { bf16_t* hrow = H + (size_t)(row0 + ai * HALF + m * 16) * INC;
#pragma unroll
                for (int bj = 0; bj < 2; ++bj) { const int col = col0 + bj * HALF;
                    if (br < 2) {
                        const u32x4 ga = *(const u32x4*)(hrow + C_GL + br * 1024 + col), gb = *(const u32x4*)(hrow + C_GL + (br + 1) * 1024 + col);
                        float r[8];
#pragma unroll
                        for (int e = 0; e < 4; ++e) { const unsigned wa = ga[e], wb = gb[e];
                            r[2 * e]     = bf_lo(wa) * __builtin_amdgcn_rcpf(bf_lo(wb));
                            r[2 * e + 1] = bf_hi(wa) * __builtin_amdgcn_rcpf(bf_hi(wb)); }
                        acc[ai][bj][m][0] *= (f32x4){r[0], r[1], r[2], r[3]}; acc[ai][bj][m][1] *= (f32x4){r[4], r[5], r[6], r[7]};
                    } else {
                        const u32x4 gc = *(const u32x4*)(hrow + C_GL + 2048 + col);
                        f32x4 g0, g1;
                        g0[0] = bf_lo(gc.x); g0[1] = bf_hi(gc.x); g0[2] = bf_lo(gc.y); g0[3] = bf_hi(gc.y);
                        g1[0] = bf_lo(gc.z); g1[1] = bf_hi(gc.z); g1[2] = bf_lo(gc.w); g1[3] = bf_hi(gc.w);
                        const f32x4 v0 = acc[ai][bj][m][0] * g0, v1 = acc[ai][bj][m][1] * g1;
                        u32x4 w; w.x = cvt_pk_bf16(v0[0], v0[1]); w.y = cvt_pk_bf16(v0[2], v0[3]); w.z = cvt_pk_bf16(v1[0], v1[1]); w.w = cvt_pk_bf16(v1[2], v1[3]);
                        *(u32x4*)(hrow + C_AZ + col) = w;
                        acc[ai][bj][m][0] = (f32x4){0.f, 0.f, 0.f, 0.f}; acc[ai][bj][m][1] = (f32x4){0.f, 0.f, 0.f, 0.f};
                    }
                    asm volatile("" ::: "memory"); } }
    }
};
struct EpiOut {
    static constexpr bool PERM = false; PG8_EPI_DEFAULTS
    const float* Yin; float* Yout; const float* stat; const float* g; const float* b;
    __device__ __forceinline__ void operator()(const f32x4 (&acc)[2][2][4][2], const Unit& u, int wr, int wc, int fr, int fq) const {
        const int row0 = u.pm * BM + wr * 64 + fr, col0 = u.pn * BM + wc * 32 + 4 * fq;
#pragma unroll
        for (int ai = 0; ai < 2; ++ai)
#pragma unroll
            for (int m = 0; m < 4; ++m) { const int r = row0 + ai * HALF + m * 16; const size_t off = (size_t)r * DM + col0;
                const float mu = stat[2 * r], rs = stat[2 * r + 1];
#pragma unroll
                for (int bj = 0; bj < 2; ++bj)
#pragma unroll
                    for (int n = 0; n < 2; ++n) { const int c = bj * HALF + n * 16; const f32x4 y = *(const f32x4*)(Yin + off + c);
                        const f32x4 gg = *(const f32x4*)(g + col0 + c), bb = *(const f32x4*)(b + col0 + c);
                        const f32x4 x = (y - mu) * rs * gg + bb;
                        *(f32x4*)(Yout + off + c) = x * ALPHA + acc[ai][bj][m][n]; }
                asm volatile("" ::: "memory"); }
    }
};

template <class Epi, class Sched, bool ALIGN_EPI = false, bool SP2 = false>
__device__ __forceinline__ void gemm_phase(PG8_LAS unsigned char* lds, const Gemm g, const Sched& S, const Epi& E) {
    const int tid = opaque_tid(), wid = __builtin_amdgcn_readfirstlane(tid >> 6), lane = tid & 63, wr = wid >> 2, wc = wid & 3, fr = lane & 15, fq = lane >> 4;
    const int K = g.K; int nt = K / BK;
    unsigned voffA[2], voffB[2];
#pragma unroll
    for (int i = 0; i < 2; ++i) { int R, C; stage_rc(tid * 16 + i * 8192, R, C); const int Rb = Epi::PERM ? ((R & ~31) + perm32(R & 31)) : R;
        voffA[i] = (unsigned)(R * g.lda + C) * 2u; voffB[i] = (unsigned)(Rb * g.ldb + C) * 2u; }
    const size_t kstep = (size_t)(BK * 2);
    const size_t hstepA = (size_t)HALF * g.lda * 2, hstepB = (size_t)HALF * g.ldb * 2;
    const size_t tstepA = 2 * hstepA, tstepB = 2 * hstepB;
    const unsigned ldsw = (unsigned)wid * 1024u;
    const int aoff = lds_byte(wr * 64 + fr, fq * 8), boff = lds_byte(wc * 32 + fr, fq * 8);
#define PG8_SA(b, h) (((b) * 2 + (h)) * HTB)
#define PG8_SB(b, h) ((4 + (b) * 2 + (h)) * HTB)
#define PG8_STAGE(bufoff, gbase, voff) do { _Pragma("unroll") for (int _i = 0; _i < 2; ++_i) \
        __builtin_amdgcn_global_load_lds((const unsigned*)((const char*)(gbase) + (voff)[_i]), (PG8_LAS unsigned*)(lds + (bufoff) + ldsw + _i * 8192), 16, 0, 0); } while (0)
#define PG8_LDA(dst, b, h) do { _Pragma("unroll") for (int m = 0; m < 4; ++m) _Pragma("unroll") for (int k = 0; k < 2; ++k) dst[m][k] = *(const PG8_LAS bf16x8*)(lds + PG8_SA(b, h) + aoff + m * 2048 + k * 1024); } while (0)
#define PG8_LDB(dst, b, h) do { _Pragma("unroll") for (int n = 0; n < 2; ++n) _Pragma("unroll") for (int k = 0; k < 2; ++k) dst[n][k] = *(const PG8_LAS bf16x8*)(lds + PG8_SB(b, h) + boff + n * 2048 + k * 1024); } while (0)
#define PG8_MMA(ai, bj, At, Bt) do { __builtin_amdgcn_s_setprio(1); _Pragma("unroll") for (int m = 0; m < 4; ++m) _Pragma("unroll") for (int n = 0; n < 2; ++n) _Pragma("unroll") for (int k = 0; k < 2; ++k) \
        acc[ai][bj][m][n] = __builtin_amdgcn_mfma_f32_16x16x32_bf16(Bt[n][k], At[m][k], acc[ai][bj][m][n], 0, 0, 0); __builtin_amdgcn_s_setprio(0); } while (0)
#define PG8_WAIT_V(n) asm volatile("s_waitcnt vmcnt(" #n ")" ::: "memory")
#define PG8_WAIT_L(n) asm volatile("s_waitcnt lgkmcnt(" #n ")" ::: "memory")
#define PG8_BAR __builtin_amdgcn_s_barrier()
#define PG8_SCHED __builtin_amdgcn_sched_barrier(0)
    Unit cur, nxt; int ui = 0;
    if (!S.next(0, cur)) return;
    f32x4 acc[2][2][4][2];
#pragma unroll
    for (int a = 0; a < 2; ++a)
#pragma unroll
        for (int b = 0; b < 2; ++b)
#pragma unroll
            for (int m = 0; m < 4; ++m)
#pragma unroll
                for (int n = 0; n < 2; ++n) acc[a][b][m][n] = (f32x4){0.f, 0.f, 0.f, 0.f};
    bf16x8 At[4][2], B0[2][2], B1[2][2];
    const char* cA = (const char*)g.A + (size_t)cur.pm * tstepA + Epi::aoff(cur); const char* cB = (const char*)g.Bt + (size_t)cur.pn * tstepB + Epi::boff(cur);
    nt = Epi::nt(cur, K / BK);
    if constexpr (SP2) {
        PG8_STAGE(PG8_SB(0, 0), cB, voffB); PG8_STAGE(PG8_SB(0, 1), cB + hstepB, voffB); PG8_STAGE(PG8_SA(0, 0), cA, voffA); PG8_STAGE(PG8_SA(0, 1), cA + hstepA, voffA);
        if (wr == 1) PG8_BAR;
        PG8_WAIT_V(2); PG8_BAR;
        PG8_STAGE(PG8_SB(1, 0), cB + kstep, voffB); PG8_STAGE(PG8_SA(1, 0), cA + kstep, voffA); PG8_STAGE(PG8_SB(1, 1), cB + hstepB + kstep, voffB);
        PG8_WAIT_V(6); PG8_BAR;
    } else {
        PG8_STAGE(PG8_SB(0, 0), cB, voffB); PG8_STAGE(PG8_SA(0, 0), cA, voffA); PG8_STAGE(PG8_SB(0, 1), cB + hstepB, voffB); PG8_STAGE(PG8_SA(0, 1), cA + hstepA, voffA);
        if (wr == 1) PG8_BAR;
        PG8_WAIT_V(4); PG8_BAR;
        PG8_STAGE(PG8_SB(1, 0), cB + kstep, voffB); PG8_STAGE(PG8_SA(1, 0), cA + kstep, voffA); PG8_STAGE(PG8_SB(1, 1), cB + hstepB + kstep, voffB);
        PG8_WAIT_V(6); PG8_BAR;
    }
    for (;;) {
        const bool has_next = S.next(ui + 1, nxt);
        const char* nA = has_next ? (const char*)g.A + (size_t)nxt.pm * tstepA + Epi::aoff(nxt) : cA; const char* nB = has_next ? (const char*)g.Bt + (size_t)nxt.pn * tstepB + Epi::boff(nxt) : cB;
        for (int t = 0; t < nt; t += 2) {
            const bool last = (t == nt - 2);
            const char* a1 = cA + (size_t)(t + 1) * kstep;
            const char* a2 = last ? nA : cA + (size_t)(t + 2) * kstep; const char* b2 = last ? nB : cB + (size_t)(t + 2) * kstep;
            const char* a3 = a2 + kstep; const char* b3 = b2 + kstep;
            if constexpr (SP2) {
            PG8_LDB(B0, 0, 0); PG8_LDB(B1, 0, 1); PG8_SCHED; PG8_LDA(At, 0, 0); PG8_STAGE(PG8_SA(1, 1), a1 + hstepA, voffA);
            PG8_WAIT_V(8); PG8_WAIT_L(0); PG8_BAR; PG8_MMA(0, 0, At, B0); PG8_MMA(0, 1, At, B1); PG8_BAR; PG8_SCHED;
            PG8_LDA(At, 0, 1); PG8_STAGE(PG8_SB(0, 0), b2, voffB); PG8_STAGE(PG8_SB(0, 1), b2 + hstepB, voffB); PG8_STAGE(PG8_SA(0, 0), a2, voffA);
            PG8_WAIT_V(8); PG8_WAIT_L(0); PG8_BAR; PG8_MMA(1, 0, At, B0); PG8_MMA(1, 1, At, B1); PG8_BAR; PG8_SCHED;
            PG8_LDB(B0, 1, 0); PG8_LDB(B1, 1, 1); PG8_SCHED; PG8_LDA(At, 1, 0); PG8_STAGE(PG8_SA(0, 1), a2 + hstepA, voffA);
            PG8_WAIT_V(8); PG8_WAIT_L(0); PG8_BAR; PG8_MMA(0, 0, At, B0); PG8_MMA(0, 1, At, B1); PG8_BAR; PG8_SCHED;
            PG8_LDA(At, 1, 1); PG8_STAGE(PG8_SB(1, 0), b3, voffB); PG8_STAGE(PG8_SB(1, 1), b3 + hstepB, voffB); PG8_STAGE(PG8_SA(1, 0), a3, voffA);
            PG8_WAIT_V(8); PG8_WAIT_L(0); PG8_BAR; PG8_MMA(1, 0, At, B0); PG8_MMA(1, 1, At, B1); PG8_BAR; PG8_SCHED;
            } else {
            PG8_LDB(B0, 0, 0); PG8_SCHED; PG8_LDA(At, 0, 0); PG8_STAGE(PG8_SA(1, 1), a1 + hstepA, voffA);
            PG8_WAIT_L(8); PG8_BAR; PG8_WAIT_L(0); PG8_MMA(0, 0, At, B0); PG8_BAR; PG8_SCHED;
            PG8_LDB(B1, 0, 1); PG8_STAGE(PG8_SB(0, 0), b2, voffB);
            PG8_BAR; PG8_WAIT_L(0); PG8_MMA(0, 1, At, B1); PG8_BAR;
            PG8_LDA(At, 0, 1); PG8_STAGE(PG8_SA(0, 0), a2, voffA);
            PG8_BAR; PG8_WAIT_L(0); PG8_MMA(1, 0, At, B0); PG8_BAR; PG8_SCHED;
            PG8_STAGE(PG8_SB(0, 1), b2 + hstepB, voffB);
            PG8_WAIT_V(6); PG8_BAR; PG8_MMA(1, 1, At, B1); PG8_BAR;
            PG8_LDB(B0, 1, 0); PG8_SCHED; PG8_LDA(At, 1, 0); PG8_STAGE(PG8_SA(0, 1), a2 + hstepA, voffA);
            PG8_WAIT_L(8); PG8_BAR; PG8_WAIT_L(0); PG8_MMA(0, 0, At, B0); PG8_BAR; PG8_SCHED;
            PG8_LDB(B1, 1, 1); PG8_STAGE(PG8_SB(1, 0), b3, voffB);
            PG8_BAR; PG8_WAIT_L(0); PG8_MMA(0, 1, At, B1); PG8_BAR;
            PG8_LDA(At, 1, 1); PG8_STAGE(PG8_SA(1, 0), a3, voffA);
            PG8_BAR; PG8_WAIT_L(0); PG8_MMA(1, 0, At, B0); PG8_BAR; PG8_SCHED;
            PG8_STAGE(PG8_SB(1, 1), b3 + hstepB, voffB);
            PG8_WAIT_V(6); PG8_BAR; PG8_MMA(1, 1, At, B1); PG8_BAR;
            }
        }
        if constexpr (ALIGN_EPI) { if (wr == 0) PG8_BAR; }
        E(acc, cur, wr, wc, fr, fq);
        if (!has_next) break;
        if constexpr (!Epi::SELFZERO) {
#pragma unroll
        for (int a = 0; a < 2; ++a)
#pragma unroll
            for (int b = 0; b < 2; ++b)
#pragma unroll
                for (int m = 0; m < 4; ++m)
#pragma unroll
                    for (int n = 0; n < 2; ++n) acc[a][b][m][n] = (f32x4){0.f, 0.f, 0.f, 0.f};
        }
        cur = nxt; cA = nA; cB = nB; ++ui; nt = Epi::nt(cur, K / BK);
        if constexpr (ALIGN_EPI) { if (wr == 1) PG8_BAR; }
    }
    PG8_WAIT_V(0);
    if constexpr (!ALIGN_EPI) { if (wr == 0) PG8_BAR; }
    PG8_BAR;
#undef PG8_SA
#undef PG8_SB
#undef PG8_STAGE
#undef PG8_LDA
#undef PG8_LDB
#undef PG8_MMA
#undef PG8_WAIT_V
#undef PG8_WAIT_L
#undef PG8_BAR
#undef PG8_SCHED
}
}

namespace att {
constexpr int D = 128, QBLK = 32, KVBLK = 64;
constexpr float THR = 8.f;
constexpr int NBUF = 3;
constexpr size_t SHM_V = KVBLK * D * 2, SHM_K = KVBLK * D * 2, SHM_ATTN = NBUF * SHM_V + NBUF * SHM_K + NWAVES * 64 * 4;
#define KSWZ(row, colB) ((row) * 256 + ((colB) ^ (((row) & 7) << 4)))
#define SBAR() __builtin_amdgcn_sched_barrier(0)
__device__ __forceinline__ int crow(int r, int hi) { return (r & 3) + 8 * (r >> 2) + 4 * hi; }
__device__ __forceinline__ bf16x8 ld8(const bf16_t* p) { return *reinterpret_cast<const bf16x8*>(p); }

__device__ __forceinline__ void partialSM(f32x16& p0, f32x16& p1, float& m_reg, float& alpha) {
  constexpr float THR2 = THR * 1.4426950408889634f;
  float pmax = p0[0];
#pragma unroll
  for (int r = 1; r < 16; ++r) pmax = fmaxf(pmax, p0[r]);
#pragma unroll
  for (int r = 0; r < 16; ++r) pmax = fmaxf(pmax, p1[r]);
  { auto rr = __builtin_amdgcn_permlane32_swap(__float_as_uint(pmax), __float_as_uint(pmax), false, false);
    pmax = fmaxf(__uint_as_float(rr[0]), __uint_as_float(rr[1])); }
  float mn;
  if (__builtin_expect(__all(pmax - m_reg <= THR2), 1)) { mn = m_reg; alpha = 1.f; }
  else { mn = fmaxf(m_reg, pmax); alpha = __builtin_amdgcn_exp2f(m_reg - mn); m_reg = mn; }
#pragma unroll
  for (int r = 0; r < 16; ++r) { p0[r] -= mn; p1[r] -= mn; }
#pragma unroll
  for (int r = 0; r < 16; ++r) p0[r] = __builtin_amdgcn_exp2f(p0[r]);
}
__device__ __forceinline__ void finishSM(f32x16& p0, f32x16& p1, float alpha, float& l_reg, bf16x8& pa0, bf16x8& pa1, bf16x8& pa2, bf16x8& pa3) {
#pragma unroll
  for (int r = 0; r < 16; ++r) p1[r] = __builtin_amdgcn_exp2f(p1[r]);
  float ps = 0;
#pragma unroll
  for (int r = 0; r < 16; ++r) ps += p0[r];
#pragma unroll
  for (int r = 0; r < 16; ++r) ps += p1[r];
  { auto rr = __builtin_amdgcn_permlane32_swap(__float_as_uint(ps), __float_as_uint(ps), false, false);
    ps = __uint_as_float(rr[0]) + __uint_as_float(rr[1]); }
  l_reg = l_reg * alpha + ps;
#define PK4(P, BASE, OUT) do { unsigned a0 = cvt_pk_bf16(P[BASE + 0], P[BASE + 1]), a1 = cvt_pk_bf16(P[BASE + 2], P[BASE + 3]);   \
    unsigned b0 = cvt_pk_bf16(P[BASE + 4], P[BASE + 5]), b1 = cvt_pk_bf16(P[BASE + 6], P[BASE + 7]);                              \
    auto r0 = __builtin_amdgcn_permlane32_swap(a0, b0, false, false); auto r1 = __builtin_amdgcn_permlane32_swap(a1, b1, false, false); \
    u32x4 w = {r0[0], r1[0], r0[1], r1[1]}; OUT = *reinterpret_cast<bf16x8*>(&w); } while (0)
  PK4(p0, 0, pa0); PK4(p0, 8, pa1); PK4(p1, 0, pa2); PK4(p1, 8, pa3);
#undef PK4
}
template <int NQ, bool QREG> __device__ __forceinline__ void qkt(f32x16& p0, f32x16& p1, const bf16_t* Ks, const bf16x8* qr, const bf16_t* Qw, int r32, int hi, int qcolB) {
  p0 = f32x16{}; p1 = f32x16{};
#pragma unroll
  for (int d0 = 0; d0 < NQ; ++d0) { int cb = qcolB + (d0 * 16 + hi * 8) * 2;
    bf16x8 b0 = *reinterpret_cast<const bf16x8*>((const char*)Ks + KSWZ(r32, cb));
    bf16x8 b1 = *reinterpret_cast<const bf16x8*>((const char*)Ks + KSWZ(32 + r32, cb));
    const bf16x8 qv = QREG ? qr[d0] : ld8(Qw + d0 * 16);
    p0 = __builtin_amdgcn_mfma_f32_32x32x16_bf16(b0, qv, p0, 0, 0, 0); p1 = __builtin_amdgcn_mfma_f32_32x32x16_bf16(b1, qv, p1, 0, 0, 0); }
  if (QREG) { __builtin_amdgcn_sched_group_barrier(0x100, 2 * NQ, 0); __builtin_amdgcn_sched_group_barrier(0x008, 2 * NQ, 0); }
}
template <int NQ> __device__ __forceinline__ void kload(bf16x8 (&kf)[2 * NQ], const bf16_t* Ks, int r32, int hi, int qcolB) {
#pragma unroll
  for (int d0 = 0; d0 < NQ; ++d0) { int cb = qcolB + (d0 * 16 + hi * 8) * 2;
    kf[2 * d0] = *reinterpret_cast<const bf16x8*>((const char*)Ks + KSWZ(r32, cb)); kf[2 * d0 + 1] = *reinterpret_cast<const bf16x8*>((const char*)Ks + KSWZ(32 + r32, cb)); }
}
template <int NQ> __device__ __forceinline__ void kmfma(f32x16& p0, f32x16& p1, const bf16x8 (&kf)[2 * NQ], const bf16x8* qr) {
  p0 = f32x16{}; p1 = f32x16{};
#pragma unroll
  for (int d0 = 0; d0 < NQ; ++d0) { p0 = __builtin_amdgcn_mfma_f32_32x32x16_bf16(kf[2 * d0], qr[d0], p0, 0, 0, 0); p1 = __builtin_amdgcn_mfma_f32_32x32x16_bf16(kf[2 * d0 + 1], qr[d0], p1, 0, 0, 0); }
}
__device__ __forceinline__ int v_st(int k, int c) { const int kk = (k & ~0xC) | ((k & 4) << 1) | ((k & 8) >> 1); return ((kk >> 3) * 4 + (c >> 5)) * 512 + ((kk & 7) * 32 + (c & 31)) * 2; }
__device__ __forceinline__ int v_rd_base(int lane) { return ((lane & 3) << 3) | (((lane >> 2) & 3) << 6) | (((lane >> 4) & 1) << 5) | (((lane >> 5) & 1) << 8); }
constexpr int v_rd_off(int d0, int ks, int half) { return d0 * 512 + ks * 4096 + half * 2048; }
typedef __attribute__((address_space(3))) const char* lds_cptr;
typedef short v4i16_t __attribute__((ext_vector_type(4)));
__device__ __forceinline__ s16x4 vtr(lds_cptr p) { return __builtin_bit_cast(s16x4, __builtin_amdgcn_ds_read_tr16_b64_v4i16((__attribute__((address_space(3))) v4i16_t*)p)); }
#define VRDK(L, H, KS) do { _Pragma("unroll") for (int d0 = 0; d0 < 4; ++d0) { L[d0] = vtr(vp + v_rd_off(d0, KS, 0)); H[d0] = vtr(vp + v_rd_off(d0, KS, 1)); } } while (0)
#define PK(L, H) (bf16x8){L[0], L[1], L[2], L[3], H[0], H[1], H[2], H[3]}
#define PVK(pa, L, H) do { _Pragma("unroll") for (int d0 = 0; d0 < 4; ++d0) o[d0] = __builtin_amdgcn_mfma_f32_32x32x16_bf16(pa, PK(L[d0], H[d0]), o[d0], 0, 0, 0); } while (0)
template <bool PIPE> __device__ __forceinline__ void pv_d0(f32x16* o, lds_cptr vp, bf16x8 pa0, bf16x8 pa1, bf16x8 pa2, bf16x8 pa3) {
  s16x4 La[4], Ha[4], Lb[4], Hb[4];
  if constexpr (!PIPE) {
    VRDK(La, Ha, 0); PVK(pa0, La, Ha); VRDK(La, Ha, 1); PVK(pa1, La, Ha); VRDK(La, Ha, 2); PVK(pa2, La, Ha); VRDK(La, Ha, 3); PVK(pa3, La, Ha);
    return;
  }
  VRDK(La, Ha, 0); VRDK(Lb, Hb, 1);
  PVK(pa0, La, Ha); VRDK(La, Ha, 2);
  PVK(pa1, Lb, Hb); VRDK(Lb, Hb, 3);
  PVK(pa2, La, Ha); PVK(pa3, Lb, Hb);
  __builtin_amdgcn_sched_group_barrier(0x100, 16, 0); __builtin_amdgcn_sched_group_barrier(0x008, 4, 0);
  __builtin_amdgcn_sched_group_barrier(0x100, 8, 0);  __builtin_amdgcn_sched_group_barrier(0x008, 4, 0);
  __builtin_amdgcn_sched_group_barrier(0x100, 8, 0);  __builtin_amdgcn_sched_group_barrier(0x008, 8, 0);
}
__device__ __forceinline__ void pv_pref(s16x4 (&La)[4], s16x4 (&Ha)[4], s16x4 (&Lb)[4], s16x4 (&Hb)[4], lds_cptr vp) { VRDK(La, Ha, 0); }
__device__ __forceinline__ void pv_rest(f32x16* o, s16x4 (&La)[4], s16x4 (&Ha)[4], s16x4 (&Lb)[4], s16x4 (&Hb)[4], lds_cptr vp, bf16x8 pa0, bf16x8 pa1, bf16x8 pa2, bf16x8 pa3) {
  VRDK(Lb, Hb, 1);
  PVK(pa0, La, Ha); VRDK(La, Ha, 2);
  PVK(pa1, Lb, Hb); VRDK(Lb, Hb, 3);
  PVK(pa2, La, Ha); PVK(pa3, Lb, Hb);
  __builtin_amdgcn_sched_group_barrier(0x100, 8, 0); __builtin_amdgcn_sched_group_barrier(0x008, 4, 0); __builtin_amdgcn_sched_group_barrier(0x100, 8, 0);  __builtin_amdgcn_sched_group_barrier(0x008, 4, 0);
  __builtin_amdgcn_sched_group_barrier(0x100, 8, 0);  __builtin_amdgcn_sched_group_barrier(0x008, 8, 0);
}
#undef VRDK
#undef PK
#undef PVK

__device__ __forceinline__ void store_gated(const f32x16* v, float* stg, bf16_t* out, const bf16_t* gate, int lane, int r32, int hi, bool write) {
#pragma unroll
  for (int d0 = 0; d0 < 4; ++d0)
#pragma unroll
    for (int r = 0; r < 16; ++r) stg[crow(r, hi) * 128 + d0 * 32 + r32] = v[d0][r];
  asm volatile("s_waitcnt lgkmcnt(0)" ::: "memory");
#pragma unroll
  for (int it = 0; it < 8; ++it) {
    const int row = it * 4 + (lane >> 4), c8 = (lane & 15) * 8;
    const f32x4 a = *(const f32x4*)(stg + row * 128 + c8), b = *(const f32x4*)(stg + row * 128 + c8 + 4);
    const u32x4 g = *(const u32x4*)(gate + (long)row * INC + c8);
    float z[8] = {bf_lo(g.x), bf_hi(g.x), bf_lo(g.y), bf_hi(g.y), bf_lo(g.z), bf_hi(g.z), bf_lo(g.w), bf_hi(g.w)};
    float y[8];
#pragma unroll
    for (int e = 0; e < 8; ++e) y[e] = (e < 4 ? a[e] : b[e - 4]) * z[e] * sigmoidf_(z[e]);
    u32x4 w; w.x = cvt_pk_bf16(y[0], y[1]); w.y = cvt_pk_bf16(y[2], y[3]); w.z = cvt_pk_bf16(y[4], y[5]); w.w = cvt_pk_bf16(y[6], y[7]);
    if (write) *(u32x4*)(out + (long)row * INC + c8) = w; else if (y[0] == 123.456f) out[0] = 0;
  }
}

__device__ __forceinline__ void store_gated_half(const float (&w)[4][8], float* stg, bf16_t* out, u32x4 g0_, u32x4 g1_, u32x4 g2_, u32x4 g3_, int lane, int r32, int hi, bool write) {
#pragma unroll
  for (int d0 = 0; d0 < 4; ++d0)
#pragma unroll
    for (int q = 0; q < 8; ++q) stg[crow(q, hi) * 128 + d0 * 32 + r32] = w[d0][q];
  asm volatile("s_waitcnt lgkmcnt(0)" ::: "memory");
#pragma unroll
  for (int it = 0; it < 4; ++it) {
    const int row = it * 4 + (lane >> 4), c8 = (lane & 15) * 8;
    const f32x4 a = *(const f32x4*)(stg + row * 128 + c8), b = *(const f32x4*)(stg + row * 128 + c8 + 4);
    const u32x4 g = (it == 0) ? g0_ : (it == 1) ? g1_ : (it == 2) ? g2_ : g3_;
    float z[8] = {bf_lo(g.x), bf_hi(g.x), bf_lo(g.y), bf_hi(g.y), bf_lo(g.z), bf_hi(g.z), bf_lo(g.w), bf_hi(g.w)};
    float y[8];
#pragma unroll
    for (int e = 0; e < 8; ++e) y[e] = (e < 4 ? a[e] : b[e - 4]) * z[e] * sigmoidf_(z[e]);
    u32x4 wv; wv.x = cvt_pk_bf16(y[0], y[1]); wv.y = cvt_pk_bf16(y[2], y[3]); wv.z = cvt_pk_bf16(y[4], y[5]); wv.w = cvt_pk_bf16(y[6], y[7]);
    if (write) *(u32x4*)(out + (long)row * INC + c8) = wv; else if (y[0] == 123.456f) out[0] = 0;
  }
}

struct Stg { bf16x8 vs0, vs1, ks0, ks1; };
struct Pre { bf16x8 q0, q1, q2, q3, vs0, vs1, ks0, ks1, vb0, vb1, kb0, kb1; };
__device__ __forceinline__ Pre pre_zero() { Pre p; const bf16x8 z_ = {}; p.q0 = z_; p.q1 = z_; p.q2 = z_; p.q3 = z_; p.vs0 = z_; p.vs1 = z_; p.ks0 = z_; p.ks1 = z_; p.vb0 = z_; p.vb1 = z_; p.kb0 = z_; p.kb1 = z_; return p; }
template <int MODE, bool WRITE = true>
__device__ __forceinline__ Pre attn_unit(bf16_t* Qb, const bf16_t* __restrict__ Kh, const bf16_t* __restrict__ Vh, const bf16_t* Gz,
                                          int seq, char* lds, const float* subg, float lam, float oscale,
                                          const Pre pin, bool have_pre, const bf16_t* Hb, int qoff_next, int kvoff_next) {
  Pre pout = pre_zero();
  constexpr int LDQ = INC, LDK = MODE == 0 ? INC : 4096, NQ = MODE == 0 ? 4 : 8;
  const int tid = opaque_tid(), wid = __builtin_amdgcn_readfirstlane(tid >> 6), lane = tid & 63, r32 = lane & 31, hi = lane >> 5;
  const int rg = MODE == 0 ? (wid & 3) : wid, comp = MODE == 0 ? (wid >> 2) : 0;
  bf16_t* V_lds = (bf16_t*)lds; bf16_t* K_lds = (bf16_t*)(lds + NBUF * SHM_V);
  float* ws = (float*)(lds + NBUF * SHM_V + NBUF * SHM_K) + wid * 64; float* li_l = ws; float* al_l = ws + 32;
  float m_run = -1e30f, l_reg = 0.f; f32x16 o[4] = {}; bf16x8 qr[NQ];
  const bf16_t* Qw = Qb + (long)(rg * QBLK + r32) * LDQ + comp * 64 + hi * 8;
  const int qcolB = comp * 128;
#pragma unroll
  for (int d0 = 0; d0 < NQ; ++d0) qr[d0] = bf16x8{};
  if (MODE == 0 && have_pre) { qr[0] = pin.q0; qr[1] = pin.q1; qr[2] = pin.q2; qr[3] = pin.q3; }
  else {
#pragma unroll
    for (int d0 = 0; d0 < NQ; ++d0) qr[d0] = ld8(Qw + d0 * 16); }
  const int sr = tid >> 4, sc = (tid & 15) * 8, vst0 = v_st(sr, sc), vst1 = v_st(32 + sr, sc);
  const lds_cptr vb0 = (lds_cptr)lds + v_rd_base(lane);
  Stg stA, stB;
  const int soff0 = sr * LDK + sc, soff1 = soff0 + 32 * LDK;
#define SLOAD(S, k0) do { const bf16_t* vt_ = Vh + (long)(k0) * LDK; const bf16_t* kt_ = Kh + (long)(k0) * LDK; \
    S.vs0 = ld8(vt_ + soff0); S.vs1 = ld8(vt_ + soff1); S.ks0 = ld8(kt_ + soff0); S.ks1 = ld8(kt_ + soff1); } while (0)
#define SWRITE(S, b) do { *(bf16x8*)((char*)V_lds + (b) * SHM_V + vst0) = S.vs0;          \
    *(bf16x8*)((char*)V_lds + (b) * SHM_V + vst1) = S.vs1; int kc = sc * 2;               \
    *(bf16x8*)((char*)K_lds + (b) * SHM_K + KSWZ(sr, kc)) = S.ks0;                       \
    *(bf16x8*)((char*)K_lds + (b) * SHM_K + KSWZ(32 + sr, kc)) = S.ks1; } while (0)
#define RESC(a) do { if (__any((a) < 1.f)) { if (hi == 0) al_l[r32] = (a); asm volatile("s_waitcnt lgkmcnt(0)" ::: "memory"); \
    _Pragma("unroll") for (int r = 0; r < 16; ++r) { const float a_ = al_l[crow(r, hi)]; _Pragma("unroll") for (int d = 0; d < 4; ++d) o[d][r] *= a_; } } } while (0)
  const int grp = wid >> 2;
  f32x16 p0, p1; float al; bf16x8 pa0, pa1, pa2, pa3; const int NT = seq / KVBLK;
  if (MODE == 0 && have_pre) { stA.vs0 = pin.vs0; stA.vs1 = pin.vs1; stA.ks0 = pin.ks0; stA.ks1 = pin.ks1; } else { SLOAD(stA, 0); }
  asm volatile("s_waitcnt vmcnt(0)" ::: "memory"); SWRITE(stA, 0);
  if constexpr (MODE == 0) { if (have_pre) { stB.vs0 = pin.vb0; stB.vs1 = pin.vb1; stB.ks0 = pin.kb0; stB.ks1 = pin.kb1; } else { SLOAD(stB, KVBLK); } if (2 < NT) SLOAD(stA, 2 * KVBLK); } else { SLOAD(stA, KVBLK); }
  __syncthreads();
#define WGBAR() asm volatile("s_waitcnt lgkmcnt(0)\n\ts_barrier" ::: "memory")
#define ROT() do { const int t_ = bprv; bprv = bcur; bcur = bnxt; bnxt = t_; } while (0)
#define MID(S, j) do { SBAR(); if ((j) + 1 < NT) { SWRITE(S, bnxt); } if ((j) + (MODE == 0 ? 3 : 2) < NT) SLOAD(S, ((j) + (MODE == 0 ? 3 : 2)) * KVBLK); SBAR(); } while (0)
#define IV0(S, j) do { const bf16_t* Kc = (const bf16_t*)((const char*)K_lds + bcur * SHM_K); const lds_cptr vbp = vb0 + bprv * (int)SHM_V; \
      SBAR(); __builtin_amdgcn_s_setprio(1); qkt<NQ, true>(p0, p1, Kc, qr, Qw, r32, hi, qcolB); \
      if ((j) > 0) pv_d0<MODE == 0>(o, vbp, pa0, pa1, pa2, pa3); \
      __builtin_amdgcn_s_setprio(0); MID(S, j); \
      partialSM(p0, p1, m_run, al); RESC(al); finishSM(p0, p1, al, l_reg, pa0, pa1, pa2, pa3); SBAR(); \
      WGBAR(); ROT(); } while (0)
#define IV1(S, j) do { const bf16_t* Kc = (const bf16_t*)((const char*)K_lds + bcur * SHM_K); const lds_cptr vbp = vb0 + bprv * (int)SHM_V; \
      if ((j) > 0) { SBAR(); partialSM(p0, p1, m_run, al); RESC(al); finishSM(p0, p1, al, l_reg, pa0, pa1, pa2, pa3); } \
      MID(S, j); \
      __builtin_amdgcn_s_setprio(1); if ((j) > 0) pv_d0<MODE == 0>(o, vbp, pa0, pa1, pa2, pa3); \
      SBAR(); qkt<NQ, true>(p0, p1, Kc, qr, Qw, r32, hi, qcolB); __builtin_amdgcn_s_setprio(0); SBAR(); \
      WGBAR(); ROT(); } while (0)
  int bprv = 2, bcur = 0, bnxt = 1;
  if constexpr (MODE == 0) {
#define JV0(S, j) do { const bf16_t* Kc = (const bf16_t*)((const char*)K_lds + bcur * SHM_K); const lds_cptr vbp = vb0 + bprv * (int)SHM_V; \
      SBAR(); __builtin_amdgcn_s_setprio(1); \
      if ((j) > 0) pv_d0<true>(o, vbp, pa0, pa1, pa2, pa3); \
      SBAR(); qkt<NQ, true>(p0, p1, Kc, qr, Qw, r32, hi, qcolB); __builtin_amdgcn_s_setprio(0); MID(S, j); \
      partialSM(p0, p1, m_run, al); RESC(al); finishSM(p0, p1, al, l_reg, pa0, pa1, pa2, pa3); SBAR(); \
      WGBAR(); ROT(); } while (0)
#define JV1(S, j) do { const bf16_t* Kc = (const bf16_t*)((const char*)K_lds + bcur * SHM_K); const lds_cptr vbp = vb0 + bprv * (int)SHM_V; \
      if ((j) > 0) { SBAR(); partialSM(p0, p1, m_run, al); RESC(al); finishSM(p0, p1, al, l_reg, pa0, pa1, pa2, pa3); } \
      MID(S, j); \
      __builtin_amdgcn_s_setprio(1); if ((j) > 0) pv_d0<true>(o, vbp, pa0, pa1, pa2, pa3); \
      SBAR(); qkt<NQ, true>(p0, p1, Kc, qr, Qw, r32, hi, qcolB); __builtin_amdgcn_s_setprio(0); SBAR(); \
      WGBAR(); ROT(); } while (0)
    if (grp == 0) {
      for (int j = 0; j < NT; j += 2) { JV0(stB, j); JV0(stA, j + 1); }
      SBAR(); pv_d0<true>(o, vb0 + bprv * (int)SHM_V, pa0, pa1, pa2, pa3);
    } else {
      for (int j = 0; j < NT; j += 2) { JV1(stB, j); JV1(stA, j + 1); }
      SBAR(); partialSM(p0, p1, m_run, al); RESC(al); finishSM(p0, p1, al, l_reg, pa0, pa1, pa2, pa3); SBAR();
      pv_d0<true>(o, vb0 + bprv * (int)SHM_V, pa0, pa1, pa2, pa3);
    }
#undef JV0
#undef JV1
  } else {
  if (grp == 0) {
    for (int j = 0; j < NT; j += 2) { IV0(stA, j); IV0(stA, j + 1); }
  } else {
    for (int j = 0; j < NT; j += 2) { IV1(stA, j); IV1(stA, j + 1); }
    SBAR(); partialSM(p0, p1, m_run, al); RESC(al); finishSM(p0, p1, al, l_reg, pa0, pa1, pa2, pa3); SBAR();
  }
  pv_d0<MODE == 0>(o, vb0 + bprv * (int)SHM_V, pa0, pa1, pa2, pa3);
  }
#undef WGBAR
#undef ROT
#undef MID
#undef IV0
#undef IV1
  if (hi == 0) li_l[r32] = l_reg; asm volatile("s_waitcnt lgkmcnt(0)" ::: "memory");
  float rli[16];
#pragma unroll
  for (int r = 0; r < 16; ++r) rli[r] = __builtin_amdgcn_rcpf(li_l[crow(r, hi)]);
#pragma unroll
  for (int d0 = 0; d0 < 4; ++d0)
#pragma unroll
    for (int r = 0; r < 16; ++r) o[d0][r] *= rli[r];
  if constexpr (MODE == 0) {
    u32x4 gq0, gq1, gq2, gq3;
    { const bf16_t* gw_ = Gz + (long)(rg * QBLK + comp * 16 + (lane >> 4)) * INC + (lane & 15) * 8;
      gq0 = *(const u32x4*)gw_; gq1 = *(const u32x4*)(gw_ + 4 * INC); gq2 = *(const u32x4*)(gw_ + 8 * INC); gq3 = *(const u32x4*)(gw_ + 12 * INC); }
    __syncthreads();
    float* xw = (float*)lds + wid * 2048 + lane; const float* xr = (const float*)lds + (wid ^ 4) * 2048 + lane;
#pragma unroll
    for (int d0 = 0; d0 < 4; ++d0)
#pragma unroll
      for (int q = 0; q < 8; ++q) xw[(d0 * 8 + q) * 64] = (comp == 0) ? o[d0][8 + q] : o[d0][q];
    __syncthreads();
    float w[4][8];
#pragma unroll
    for (int d0 = 0; d0 < 4; ++d0)
#pragma unroll
      for (int q = 0; q < 8; ++q) { const float x = xr[(d0 * 8 + q) * 64]; w[d0][q] = (comp == 0) ? (o[d0][q] - lam * x) : (x - lam * o[d0][8 + q]); }
    if (qoff_next >= 0) {
      const bf16_t* Qwn = Hb + qoff_next + (long)(rg * QBLK + r32) * LDQ + comp * 64 + hi * 8; const bf16_t* Kh_next = Hb + kvoff_next + C_K; const bf16_t* Vh_next = Hb + kvoff_next + C_V;
      pout.q0 = ld8(Qwn); pout.q1 = ld8(Qwn + 16); pout.q2 = ld8(Qwn + 32); pout.q3 = ld8(Qwn + 48);
      pout.vs0 = ld8(Vh_next + soff0); pout.vs1 = ld8(Vh_next + soff1); pout.ks0 = ld8(Kh_next + soff0); pout.ks1 = ld8(Kh_next + soff1);
      pout.vb0 = ld8(Vh_next + KVBLK * LDK + soff0); pout.vb1 = ld8(Vh_next + KVBLK * LDK + soff1); pout.kb0 = ld8(Kh_next + KVBLK * LDK + soff0); pout.kb1 = ld8(Kh_next + KVBLK * LDK + soff1);
    }
    float g4[4];
#pragma unroll
    for (int d0 = 0; d0 < 4; ++d0) g4[d0] = subg[d0 * 32 + r32] * oscale;
#pragma unroll
    for (int q = 0; q < 8; ++q) {
      float ss = w[0][q] * w[0][q] + w[1][q] * w[1][q] + w[2][q] * w[2][q] + w[3][q] * w[3][q];
      ss += __shfl_xor(ss, 1); ss += __shfl_xor(ss, 2); ss += __shfl_xor(ss, 4); ss += __shfl_xor(ss, 8); ss += __shfl_xor(ss, 16);
      const float rs = __builtin_amdgcn_rsqf(ss * (1.f / 128.f) + SUBLN_EPS);
#pragma unroll
      for (int d0 = 0; d0 < 4; ++d0) w[d0][q] *= rs * g4[d0];
    }
    store_gated_half(w, (float*)lds + 16384 + wid * 2048, Qb + (long)(rg * QBLK + comp * 16) * INC, gq0, gq1, gq2, gq3, lane, r32, hi, WRITE);
  } else {
    __syncthreads();
    store_gated(o, (float*)lds + wid * 4096, Qb + (long)(rg * QBLK) * INC, Gz + (long)(rg * QBLK) * INC, lane, r32, hi, WRITE);
  }
  __syncthreads();
  return pout;
#undef SLOAD
#undef SWRITE
#undef RESC
}
#undef KSWZ
#undef SBAR
}

__device__ __forceinline__ float wave_sum(float v) {
#pragma unroll
    for (int o = 1; o < 64; o <<= 1) v += __shfl_xor(v, o);
    return v;
}
__device__ __forceinline__ void transpose_item(const float* W, int K, int N, bf16_t* WT, int ldt, float* scr, int kb, int nb, int lane) {
    const int k0 = 64 * kb, n0 = 32 * nb;
#pragma unroll 8
    for (int i = 0; i < 32; ++i) { const int kk = 2 * i + (lane >> 5); scr[kk * 33 + (lane & 31)] = W[(size_t)(k0 + kk) * N + n0 + (lane & 31)]; }
    asm volatile("s_waitcnt lgkmcnt(0)" ::: "memory");
    const int c = lane & 7;
#pragma unroll
    for (int j = 0; j < 4; ++j) { const int n = (lane >> 3) + 8 * j; const float* s = scr + (8 * c) * 33 + n;
        u32x4 o; o.x = cvt_pk_bf16(s[0 * 33], s[1 * 33]); o.y = cvt_pk_bf16(s[2 * 33], s[3 * 33]); o.z = cvt_pk_bf16(s[4 * 33], s[5 * 33]); o.w = cvt_pk_bf16(s[6 * 33], s[7 * 33]);
        *(u32x4*)(WT + (size_t)(n0 + n) * ldt + k0 + 8 * c) = o; }
    asm volatile("s_waitcnt lgkmcnt(0)" ::: "memory");
}
__device__ __forceinline__ void ln_row(const float* xrow, const float* g, const float* b, float* orow, bf16_t* obrow, int lane, float* st, bool wx) {
    const f32x4* xr = (const f32x4*)xrow + lane;
    f32x4 v[4]; float s = 0.f;
#pragma unroll
    for (int j = 0; j < 4; ++j) { v[j] = xr[64 * j]; s += (v[j].x + v[j].y) + (v[j].z + v[j].w); }
    const float mean = wave_sum(s) * (1.f / DM); float s2 = 0.f;
#pragma unroll
    for (int j = 0; j < 4; ++j) { v[j] = v[j] - mean; s2 += (v[j].x * v[j].x + v[j].y * v[j].y) + (v[j].z * v[j].z + v[j].w * v[j].w); }
    const float rstd = 1.f / sqrtf(wave_sum(s2) * (1.f / DM) + LN_EPS);
    if (lane == 0) { st[0] = mean; st[1] = rstd; }
#pragma unroll
    for (int j = 0; j < 4; ++j) { const f32x4 gg = ((const f32x4*)g)[lane + 64 * j], bb = ((const f32x4*)b)[lane + 64 * j];
        const f32x4 y = v[j] * rstd * gg + bb;
        if (wx) ((f32x4*)orow)[lane + 64 * j] = y;
        u32x2 w; w.x = cvt_pk_bf16(y.x, y.y); w.y = cvt_pk_bf16(y.z, y.w);
        ((u32x2*)obrow)[lane + 64 * j] = w; }
}
__device__ __forceinline__ void ln_row2(const float* x0, const float* x1, const float* g, const float* b, float* o0, float* o1, bf16_t* ob0, bf16_t* ob1, int lane, float* st0, float* st1, bool wx) {
    const f32x4* xr0 = (const f32x4*)x0 + lane; const f32x4* xr1 = (const f32x4*)x1 + lane;
    f32x4 v[4], w[4]; float s = 0.f, t = 0.f;
#pragma unroll
    for (int j = 0; j < 4; ++j) { v[j] = xr0[64 * j]; w[j] = xr1[64 * j]; }
#pragma unroll
    for (int j = 0; j < 4; ++j) { s += (v[j].x + v[j].y) + (v[j].z + v[j].w); t += (w[j].x + w[j].y) + (w[j].z + w[j].w); }
    const float mean0 = wave_sum(s) * (1.f / DM), mean1 = wave_sum(t) * (1.f / DM); float s2 = 0.f, t2 = 0.f;
#pragma unroll
    for (int j = 0; j < 4; ++j) { v[j] = v[j] - mean0; w[j] = w[j] - mean1; s2 += (v[j].x * v[j].x + v[j].y * v[j].y) + (v[j].z * v[j].z + v[j].w * v[j].w); t2 += (w[j].x * w[j].x + w[j].y * w[j].y) + (w[j].z * w[j].z + w[j].w * w[j].w); }
    const float rstd0 = 1.f / sqrtf(wave_sum(s2) * (1.f / DM) + LN_EPS), rstd1 = 1.f / sqrtf(wave_sum(t2) * (1.f / DM) + LN_EPS);
    if (lane == 0) { st0[0] = mean0; st0[1] = rstd0; st1[0] = mean1; st1[1] = rstd1; }
#pragma unroll
    for (int j = 0; j < 4; ++j) { const f32x4 gg = ((const f32x4*)g)[lane + 64 * j], bb = ((const f32x4*)b)[lane + 64 * j];
        const f32x4 y0 = v[j] * rstd0 * gg + bb, y1 = w[j] * rstd1 * gg + bb;
        if (wx) { ((f32x4*)o0)[lane + 64 * j] = y0; ((f32x4*)o1)[lane + 64 * j] = y1; }
        u32x2 p0; p0.x = cvt_pk_bf16(y0.x, y0.y); p0.y = cvt_pk_bf16(y0.z, y0.w); ((u32x2*)ob0)[lane + 64 * j] = p0;
        u32x2 p1; p1.x = cvt_pk_bf16(y1.x, y1.y); p1.y = cvt_pk_bf16(y1.z, y1.w); ((u32x2*)ob1)[lane + 64 * j] = p1; }
}
__device__ __forceinline__ void ln_row_final(float* xrow, const float* g, const float* b, int lane) {
    f32x4* xr = (f32x4*)xrow + lane;
    f32x4 v[4]; float s = 0.f;
#pragma unroll
    for (int j = 0; j < 4; ++j) { v[j] = xr[64 * j]; s += (v[j].x + v[j].y) + (v[j].z + v[j].w); }
    const float mean = wave_sum(s) * (1.f / DM); float s2 = 0.f;
#pragma unroll
    for (int j = 0; j < 4; ++j) { v[j] = v[j] - mean; s2 += (v[j].x * v[j].x + v[j].y * v[j].y) + (v[j].z * v[j].z + v[j].w * v[j].w); }
    const float rstd = 1.f / sqrtf(wave_sum(s2) * (1.f / DM) + LN_EPS);
#pragma unroll
    for (int j = 0; j < 4; ++j) { const f32x4 gg = ((const f32x4*)g)[lane + 64 * j], bb = ((const f32x4*)b)[lane + 64 * j]; xr[64 * j] = v[j] * rstd * gg + bb; }
}
__device__ __forceinline__ void sincos_d(double a, double& s, double& c) {
    const double k = rint(a * 0.63661977236758134308);
    double r = fma(-k, 1.57079632679489655800e+00, a); r = fma(-k, 6.12323399573676603587e-17, r);
    const int q = (int)((long long)k & 3);
    const double r2 = r * r;
    const double sp = r * (1.0 + r2 * (-1.0 / 6 + r2 * (1.0 / 120 + r2 * (-1.0 / 5040 + r2 * (1.0 / 362880 + r2 * (-1.0 / 39916800 + r2 * (1.0 / 6227020800.0 + r2 * (-1.0 / 1307674368000.0))))))));
    const double cp = 1.0 + r2 * (-0.5 + r2 * (1.0 / 24 + r2 * (-1.0 / 720 + r2 * (1.0 / 40320 + r2 * (-1.0 / 3628800 + r2 * (1.0 / 479001600.0 + r2 * (-1.0 / 87178291200.0 + r2 * (1.0 / 20922789888000.0))))))));
    s = (q == 0) ? sp : (q == 1) ? cp : (q == 2) ? -sp : -cp;
    c = (q == 0) ? cp : (q == 1) ? -sp : (q == 2) ? -cp : sp;
}


#define LAS __attribute__((address_space(3)))
#define XB_TMO      128
#define XB_XCNT(j)  (256  + 64 * (j))
#define XB_XSUB(j)  (1280 + 64 * (j))
#define XB_XGEN(j)  (2304 + 64 * (j))
#define XB_TOP      3328
#define XB_TOPGEN   3392
#define XCD_BAR_WORDS 3456
#define XB_SPIN_CAP (1u << 18)
__device__ __forceinline__ unsigned xb_ld(unsigned* p)              { return __hip_atomic_load(p, __ATOMIC_RELAXED, __HIP_MEMORY_SCOPE_AGENT); }
__device__ __forceinline__ unsigned xb_add(unsigned* p, unsigned v) { return __hip_atomic_fetch_add(p, v, __ATOMIC_RELAXED, __HIP_MEMORY_SCOPE_AGENT); }
__device__ __forceinline__ unsigned xb_xcc_id() { return (unsigned)__builtin_amdgcn_s_getreg((3 << 11) | 20) & 0xFu; }
#define XB_SPIN(cond, bar) do { unsigned _sp = 0; while (cond) { __builtin_amdgcn_s_sleep(1); \
    if ((++_sp & 255u) == 0u) { if (xb_ld(&(bar)[XB_TMO])) break; if (_sp > XB_SPIN_CAP) { atomicAdd(&(bar)[XB_TMO], 1u); break; } } } } while (0)
struct XcdBarrier { unsigned* bar; unsigned x; volatile LAS unsigned* st; };
__device__ __forceinline__ XcdBarrier xcd_barrier_post(unsigned* bar, volatile LAS unsigned* st) {
    XcdBarrier b; b.bar = bar; b.x = xb_xcc_id(); b.st = st;
    if (threadIdx.x == 0) (void)xb_add(&bar[XB_XCNT(b.x)], 1u);
    return b;
}
__device__ __forceinline__ void xcd_barrier_complete(unsigned* bar, unsigned x, unsigned& nloc, unsigned& nx) {
    const unsigned G = gridDim.x * gridDim.y * gridDim.z;
    unsigned sum, cnt, mine, sp = 0u;
    for (;;) {
        sum = 0u; cnt = 0u; mine = 0u;
#pragma unroll
        for (unsigned j = 0; j < 16; ++j) { const unsigned c = xb_ld(&bar[XB_XCNT(j)]); sum += c; cnt += (c > 0u) ? 1u : 0u; mine = (j == x) ? c : mine; }
        if (sum == G) break;
        __builtin_amdgcn_s_sleep(1);
        if ((++sp & 255u) == 0u) { if (xb_ld(&bar[XB_TMO])) break; if (sp > XB_SPIN_CAP) { atomicAdd(&bar[XB_TMO], 1u); break; } }
    }
    nloc = mine > 0u ? mine : 1u; nx = cnt > 0u ? cnt : 1u;
}
__device__ __forceinline__ void xcd_barrier(const XcdBarrier& b) {
    asm volatile("s_waitcnt vmcnt(0)" ::: "memory");
    __syncthreads();
    if (threadIdx.x == 0) {
        unsigned* bar = b.bar;
        __builtin_amdgcn_s_waitcnt(0);
        unsigned nloc = b.st[0], nx = b.st[1];
        if (nloc == 0u) { xcd_barrier_complete(bar, b.x, nloc, nx); b.st[0] = nloc; b.st[1] = nx; }
        const unsigned old = xb_add(&bar[XB_XSUB(b.x)], 1u);
        const unsigned gen = old / nloc;
        if (old + 1u == (gen + 1u) * nloc) {
            __builtin_amdgcn_fence(__ATOMIC_RELEASE, "agent");
            asm volatile("s_waitcnt vmcnt(0)" ::: "memory");
            const unsigned og = xb_add(&bar[XB_TOP], 1u);
            const unsigned tg = og / nx;
            if (og + 1u == (tg + 1u) * nx) xb_add(&bar[XB_TOPGEN], 1u);
            else XB_SPIN(xb_ld(&bar[XB_TOPGEN]) == tg, bar);
            __builtin_amdgcn_fence(__ATOMIC_ACQUIRE, "agent");
            xb_add(&bar[XB_XGEN(b.x)], 1u);
            asm volatile("s_waitcnt vmcnt(0)" ::: "memory");
        } else {
            XB_SPIN(xb_ld(&bar[XB_XGEN(b.x)]) == gen, bar);
            __builtin_amdgcn_fence(__ATOMIC_ACQUIRE, "agent");
            asm volatile("s_waitcnt vmcnt(0)" ::: "memory");
        }
    }
    __syncthreads();
}

struct Args { const float* in[21]; float* out; unsigned char* ws; int CH; int pad; };
constexpr int LDS_BYTES = 131072 + 1024;

__global__ void __launch_bounds__(NWAVES * 64, 2) mega_fwd(Args args) {
    extern __shared__ __attribute__((aligned(16))) unsigned char lds[];
    cg::grid_group grid = cg::this_grid();
    const int tid = threadIdx.x, lane = tid & 63, wave = __builtin_amdgcn_readfirstlane(tid >> 6);
    const int G = gridDim.x, bx = blockIdx.x;
    const int vcu = (G % 8 == 0) ? (bx % 8) * (G / 8) + bx / 8 : bx;
    unsigned char* ws = args.ws;
    float* lamv = (float*)(ws + WS_CTL);
    float* rope = (float*)(ws + WS_ROPE);
    bf16_t* Win_t = (bf16_t*)(ws + WS_WIN); bf16_t* Wmem_t = (bf16_t*)(ws + WS_WMEM); bf16_t* Wbr_t = (bf16_t*)(ws + WS_WBA);
    bf16_t* Wout_t = (bf16_t*)(ws + WS_WOUT);
    bf16_t* memb = (bf16_t*)(ws + WS_MEMB); bf16_t* kvm = (bf16_t*)(ws + WS_KVM); bf16_t* xb = (bf16_t*)(ws + WS_XB); bf16_t* Hc = (bf16_t*)(ws + WS_H);
    float* rstat = (float*)(ws + WS_H + (size_t)args.CH * INC * 2);
    float* X = args.out;
    const int CH = args.CH, nchunk = NTOK / CH;
    PG8_LAS unsigned char* lds3 = (PG8_LAS unsigned char*)lds;
    volatile LAS unsigned* MISC = (volatile LAS unsigned*)(lds3 + 131072);
    if (tid < 64) MISC[tid] = 0u;
    __syncthreads();
    const XcdBarrier xbar = xcd_barrier_post((unsigned*)(ws + WS_BAR), MISC + 8);
#define GRID_BAR() xcd_barrier(xbar)

    {
        for (int it = bx; it < 256; it += G) {
            const int L = it >> 6, g = (it >> 4) & 3, k0 = (it & 15) * 64;
            float* Wt = (float*)lds; float* Pw = Wt + 64 * 129;
            const float* wsrc = args.in[6] + ((size_t)L * DM + k0) * INC + g * 128;
            for (int e = tid; e < 64 * 128; e += 512) { const int r = e >> 7, c = e & 127; Wt[r * 129 + c] = wsrc[(size_t)r * INC + c]; }
            const float* psrc = args.in[8] + (size_t)(L * 4 + g) * 128 * 128;
            for (int e = tid; e < 128 * 128; e += 512) Pw[e] = psrc[e];
            __syncthreads();
            const int k = tid & 63, dg = tid >> 6;
            float acc[16];
#pragma unroll
            for (int j = 0; j < 16; ++j) acc[j] = 0.f;
            for (int c = 0; c < 128; ++c) { const float a = Wt[k * 129 + c];
#pragma unroll
                for (int j4 = 0; j4 < 4; ++j4) { const f32x4 p = *(const f32x4*)(Pw + c * 128 + dg * 16 + j4 * 4);
                    acc[j4 * 4 + 0] += a * p.x; acc[j4 * 4 + 1] += a * p.y; acc[j4 * 4 + 2] += a * p.z; acc[j4 * 4 + 3] += a * p.w; } }
            bf16_t* dst = Win_t + ((size_t)L * INC + g * 128 + dg * 16) * DM + k0 + k;
#pragma unroll
            for (int j = 0; j < 16; ++j) dst[(size_t)j * DM] = (bf16_t)(cvt_pk_bf16(acc[j], 0.f) & 0xffffu);
            __syncthreads();
        }
        const int gw = bx * NWAVES + wave, NGW = G * NWAVES;
        float* scr = (float*)(lds + wave * 16384);
        constexpr int I_IN = 16 * 272, I_SQ = 16 * 32, I_HF = 8 * 32, I_L = I_IN + 3 * I_SQ + 2 * I_HF;
        for (int it = gw; it < DEPTH * I_L; it += NGW) {
            const int L = it / I_L; int r = it % I_L;
            if (r < I_IN) { transpose_item(args.in[6] + (size_t)L * DM * INC, DM, INC, Win_t + (size_t)L * INC * DM, DM, scr, r / 272, 16 + r % 272, lane); continue; } r -= I_IN;
            if (r < I_SQ) { transpose_item(args.in[7] + (size_t)L * DM * DM, DM, DM, Wmem_t + (size_t)L * DM * DM, DM, scr, r / 32, r % 32, lane); continue; } r -= I_SQ;
            if (r < I_HF) { transpose_item(args.in[15] + (size_t)L * 512 * DM, 512, DM, Wbr_t + (size_t)L * DM * 2048, 2048, scr, r / 32, r % 32, lane); continue; } r -= I_HF;
            if (r < I_SQ) { transpose_item(args.in[16] + (size_t)L * DM * DM, DM, DM, Wbr_t + (size_t)L * DM * 2048 + 512, 2048, scr, r / 32, r % 32, lane); continue; } r -= I_SQ;
            if (r < I_HF) { transpose_item(args.in[17] + (size_t)L * 512 * DM, 512, DM, Wbr_t + (size_t)L * DM * 2048 + 1536, 2048, scr, r / 32, r % 32, lane); continue; } r -= I_HF;
            transpose_item(args.in[18] + (size_t)L * DM * DM, DM, DM, Wout_t + (size_t)L * DM * DM, DM, scr, r / 32, r % 32, lane);
        }
        for (int m = gw; m < MEMROWS; m += NGW) {
            const float* src = (m < 1024) ? args.in[2] + (size_t)m * DM : args.in[3] + (size_t)(m - 1024) * DM;
#pragma unroll
            for (int j = 0; j < 4; ++j) { const f32x4 v = ((const f32x4*)src)[lane + 64 * j]; u32x2 w; w.x = cvt_pk_bf16(v.x, v.y); w.y = cvt_pk_bf16(v.z, v.w); ((u32x2*)(memb + (size_t)m * DM))[lane + 64 * j] = w; }
        }
        for (int m = gw; m < NTOK; m += 2 * NGW) {
            const int m1 = m + NGW;
            const float* src = (m < NP) ? args.in[0] + (size_t)m * DM : args.in[1] + (size_t)(m - NP) * DM;
            if (m1 < NTOK) { const float* src1 = (m1 < NP) ? args.in[0] + (size_t)m1 * DM : args.in[1] + (size_t)(m1 - NP) * DM;
                ln_row2(src, src1, args.in[4], args.in[5], X + (size_t)m * DM, X + (size_t)m1 * DM, xb + (size_t)m * DM, xb + (size_t)m1 * DM, lane, rstat + 2 * (size_t)m, rstat + 2 * (size_t)m1, false); }
            else ln_row(src, args.in[4], args.in[5], X + (size_t)m * DM, xb + (size_t)m * DM, lane, rstat + 2 * (size_t)m, false);
        }
        for (int e = bx * 512 + tid; e < SP * 8; e += G * 512) {
            const int pos = e >> 3, j = e & 7;
            const double inv = (j == 0) ? 1.0 : (j == 1) ? 0.19392274474868576 : (j == 2) ? 0.03760603093086393 : (j == 3) ? 0.007292664737217109 :
                               (j == 4) ? 0.001414213562373095 : (j == 5) ? 0.0002742481756762073 : (j == 6) ? 5.318295896944988e-05 : 1.031338537721246e-05;
            double s, c; sincos_d((double)pos * inv, s, c);
            rope[pos * 16 + j] = (float)c; rope[pos * 16 + 8 + j] = (float)s;
        }
        if (bx == 0 && wave == 0) {
            for (int L = 0; L < DEPTH; ++L) {
                const float d1 = wave_sum(args.in[10][L * 64 + lane] * args.in[11][L * 64 + lane]);
                const float d2 = wave_sum(args.in[12][L * 64 + lane] * args.in[13][L * 64 + lane]);
                const float li = (L == 0) ? 0.20000000000000007f : (L == 1) ? 0.35550906759096934f : (L == 2) ? 0.4707130183435842f : 0.5560582041556406f;
                if (lane == 0) { lamv[L] = expf(d1) - expf(d2) + li; lamv[4 + L] = 1.f - li; }
            }
        }
    }
    grid.sync();
    {
        pg8::Gemm g{memb, Wmem_t, MEMROWS, 4096, DM, DM, DM}; pg8::StaticOrder S; S.init(MEMROWS, 4096, G, bx);
        pg8::EpiStore E{kvm, 4096};
        pg8::gemm_phase<pg8::EpiStore, pg8::StaticOrder, true, true>(lds3, g, S, E);
    }
    const int gw = bx * NWAVES + wave, NGW = G * NWAVES;
    for (int L = 0; L < DEPTH; ++L) {
        for (int c = 0; c < nchunk; ++c) {
            const int row0g = c * CH; const bool prompt = row0g < NP; const int S_ = prompt ? SP : SS;
            {
                pg8::Gemm g{xb + (size_t)row0g * DM, Win_t + (size_t)L * INC * DM, CH, INC, DM, DM, DM}; pg8::StaticOrder S; S.init(CH, INC, G, bx);
                pg8::EpiIn E{Hc, rope, row0g, S_ - 1};
                pg8::gemm_phase<pg8::EpiIn, pg8::StaticOrder, true, true>(lds3, g, S, E);
#if PROBE_P1X2
                pg8::gemm_phase<pg8::EpiIn, pg8::StaticOrder, true, true>(lds3, g, S, E);
#endif
            }
            GRID_BAR();
            {
                const float lam = lamv[L], oscale = lamv[4 + L];
                const int nqb = S_ / 128, nUA = (CH / 128) * 8;
                att::Pre pre = att::pre_zero(); bool have = false;
                for (int u = vcu; u < nUA; u += G) {
                    const int bh = u / nqb, qb = u % nqb, bl = bh >> 3, hd = bh & 7;
                    bf16_t* base = Hc + (size_t)(bl * S_) * INC + hd * 128;
                    const int un = u + G; const bool hn = un < nUA; const int u2 = hn ? un : u;
                    const int bh2 = u2 / nqb, qb2 = u2 % nqb;
                    const int kvo = ((bh2 >> 3) * S_) * INC + (bh2 & 7) * 128;
                    pre = att::attn_unit<0>(base + (size_t)(qb * 128) * INC + C_Q, base + C_K, base + C_V, base + (size_t)(qb * 128) * INC + C_AZ,
                                      S_, (char*)lds, args.in[14] + L * 128, lam, oscale,
                                      pre, have, Hc, hn ? kvo + (qb2 * 128) * INC + C_Q : -1, kvo);
                    have = hn;
                }
                const int nUC = (CH / 256) * 4;
                for (int u = vcu; u < nUC; u += G) {
                    const int rb = u >> 2, hd = u & 3; const int grow = row0g + rb * 256;
                    const int mb = (grow < NP) ? (grow / SP) : (4 + (grow - NP) / SS);
                    bf16_t* qp = Hc + (size_t)(rb * 256) * INC + hd * 128;
                    const bf16_t* kp = kvm + (size_t)(mb * 256) * 4096 + L * 1024 + hd * 128;
                    { att::Pre dummy = att::pre_zero(); (void)att::attn_unit<1>(qp + C_XQ, kp, kp + 512, qp + C_XZ, 256, (char*)lds, nullptr, 0.f, 0.f, dummy, false, nullptr, -1, 0); }
                }
                const int nUP = CH / 64;
                for (int u = bx; u < nUP; u += G) {
                    const int tidp = opaque_tid();
                    const int t0 = u * 64, s0 = (row0g + t0) & (S_ - 1);
                    const bf16_t* sq = Hc + (size_t)(t0 - s0) * INC;
                    unsigned* ubuf = (unsigned*)lds;
                    const int cp = tidp & 255, th = tidp >> 8, ch = cp * 2, half = 1 << (cp >> 6);
                    unsigned wz[32];
#pragma unroll
                    for (int i = 0; i < 32; ++i) wz[i] = *(const unsigned*)(sq + (size_t)(s0 + th * 32 + i) * INC + C_PZ + ch);
#pragma unroll 8
                    for (int it = 0; it < 40; ++it) { const int e = tidp + it * 512; const int r = e >> 8, cq = e & 255, sr_ = s0 - 8 + r;
                        if (e < 79 * 256 && sr_ >= 0 && sr_ < S_) ubuf[e] = *(const unsigned*)(sq + (size_t)sr_ * INC + 2 * cq); }
                    const float ps0 = args.in[9][L * 512 + ch], ps1 = args.in[9][L * 512 + ch + 1];
                    __syncthreads();
                    {
                        const int sf = s0 + th * 32;
                        int lo = sf - half; if (lo < 0) lo = 0;
                        int hi_ = sf + half - 1; if (hi_ > S_ - 1) hi_ = S_ - 1;
                        float a0 = 0.f, a1 = 0.f;
                        for (int r = lo; r <= hi_; ++r) { const unsigned w = ubuf[(r - s0 + 8) * 256 + cp]; a0 += bf_lo(w); a1 += bf_hi(w); }
#pragma unroll
                        for (int i = 0; i < 32; ++i) {
                            const int ti = th * 32 + i, s = sf + i;
                            const unsigned wu = ubuf[(ti + 8) * 256 + cp];
                            const float rc = __builtin_amdgcn_rcpf((float)(hi_ - lo + 1));
                            const float d0 = a0 * rc - bf_lo(wu), d1 = a1 * rc - bf_hi(wu);
                            const float z0 = bf_lo(wz[i]), z1 = bf_hi(wz[i]);
                            const float y0 = d0 * ps0 * z0 * sigmoidf_(z0), y1 = d1 * ps1 * z1 * sigmoidf_(z1);
                            *(unsigned*)(Hc + (size_t)(t0 + ti) * INC + C_PZ + ch) = cvt_pk_bf16(y0, y1);
                            const int nlo = (s + 1 - half) < 0 ? 0 : (s + 1 - half);
                            const int nhi = (s + half) > (S_ - 1) ? (S_ - 1) : (s + half);
                            if (nhi > hi_) { const unsigned w = ubuf[(nhi - s0 + 8) * 256 + cp]; a0 += bf_lo(w); a1 += bf_hi(w); }
                            if (nlo > lo) { const unsigned w = ubuf[(lo - s0 + 8) * 256 + cp]; a0 -= bf_lo(w); a1 -= bf_hi(w); }
                            lo = nlo; hi_ = nhi;
                        }
                    }
                    __syncthreads();
                }
            }
            GRID_BAR();
            {
                pg8::Order3 S; S.base.init(CH, DM, G, bx);
                pg8::Gemm g{Hc, Wbr_t + (size_t)L * DM * 2048, CH, DM, DM, INC, 2048};
                pg8::EpiBr3 E{Hc};
                pg8::gemm_phase<pg8::EpiBr3, pg8::Order3, true, true>(lds3, g, S, E);
            }
            GRID_BAR();
            {
                pg8::Gemm g{Hc + C_AZ, Wout_t + (size_t)L * DM * DM, CH, DM, DM, INC, DM}; pg8::StaticOrder S; S.init(CH, DM, G, bx);
                const float* yin = (L > 0) ? X + (size_t)row0g * DM : (row0g < NP ? args.in[0] + (size_t)row0g * DM : args.in[1] + (size_t)(row0g - NP) * DM);
                pg8::EpiOut E{yin, X + (size_t)row0g * DM, rstat + 2 * (size_t)row0g, (L > 0) ? args.in[19] + (L - 1) * DM : args.in[4], (L > 0) ? args.in[20] + (L - 1) * DM : args.in[5]};
                pg8::gemm_phase<pg8::EpiOut, pg8::StaticOrder, true, true>(lds3, g, S, E);
            }
            GRID_BAR();
            if (L == DEPTH - 1) { const int lane6 = opaque_tid() & 63;
              for (int m = row0g + gw; m < row0g + CH; m += NGW) ln_row_final(X + (size_t)m * DM, args.in[19] + L * DM, args.in[20] + L * DM, lane6); }
            else
            { const int lane5 = opaque_tid() & 63;
              for (int m = row0g + gw; m < row0g + CH; m += 2 * NGW) {
                const int m1 = m + NGW;
                if (m1 < row0g + CH) ln_row2(X + (size_t)m * DM, X + (size_t)m1 * DM, args.in[19] + L * DM, args.in[20] + L * DM, X + (size_t)m * DM, X + (size_t)m1 * DM, xb + (size_t)m * DM, xb + (size_t)m1 * DM, lane5, rstat + 2 * (size_t)m, rstat + 2 * (size_t)m1, L == DEPTH - 1);
                else ln_row(X + (size_t)m * DM, args.in[19] + L * DM, args.in[20] + L * DM, X + (size_t)m * DM, xb + (size_t)m * DM, lane5, rstat + 2 * (size_t)m, L == DEPTH - 1); } }
#if PROBE_SYNC
            for (int q = 0; q < 20; ++q) grid.sync();
#endif
        }
    }
}

extern "C" void kernel_launch(void* const* d_in, const int* in_sizes, int n_in, void* d_out, int out_size, void* d_ws, size_t ws_size, hipStream_t stream) {
    static int grid = 0;
    if (grid == 0) {
        int dev = 0, cus = 0, per_cu = 0;
        if (hipGetDevice(&dev) != hipSuccess || hipDeviceGetAttribute(&cus, hipDeviceAttributeMultiprocessorCount, dev) != hipSuccess) { fprintf(stderr, "kernel_launch: device query failed\n"); grid = -1; return; }
        if (hipFuncSetAttribute((const void*)mega_fwd, hipFuncAttributeMaxDynamicSharedMemorySize, LDS_BYTES) != hipSuccess) { fprintf(stderr, "kernel_launch: hipFuncSetAttribute failed\n"); grid = -1; return; }
        if (hipOccupancyMaxActiveBlocksPerMultiprocessor(&per_cu, (const void*)mega_fwd, NWAVES * 64, LDS_BYTES) != hipSuccess || per_cu < 1) { fprintf(stderr, "kernel_launch: occupancy query failed (%d)\n", per_cu); (void)hipGetLastError(); per_cu = 1; }
        grid = cus * per_cu;
    }
    if (grid < 0) return;
    Args a{};
    for (int i = 0; i < 21; ++i) a.in[i] = (const float*)d_in[i];
    a.out = (float*)d_out; a.ws = (unsigned char*)d_ws;
    int CH = 32768;
    while (CH > 8192 && WS_H + (size_t)CH * INC * 2 + (size_t)NTOK * 8 > ws_size) CH >>= 1;
    if (WS_H + (size_t)CH * INC * 2 + (size_t)NTOK * 8 > ws_size) { fprintf(stderr, "kernel_launch: workspace too small (%zu)\n", ws_size); return; }
    a.CH = CH; a.pad = 0;
    if (hipMemsetAsync((char*)d_ws + WS_BAR, 0, BAR_BYTES, stream) != hipSuccess) { fprintf(stderr, "kernel_launch: memset failed\n"); return; }
    void* kargs[] = {&a};
    hipError_t e = hipLaunchCooperativeKernel((const void*)mega_fwd, dim3(grid), dim3(NWAVES * 64), kargs, LDS_BYTES, stream);
    if (e != hipSuccess) fprintf(stderr, "kernel_launch: cooperative launch failed: %s (grid %d)\n", hipGetErrorString(e), grid);
}
```

```cpp
#include <hip/hip_runtime.h>
#include <hip/hip_cooperative_groups.h>
#include <cstdio>
#include <cstdint>
namespace cg = cooperative_groups;
#define PROBE_ATT2 0
#define PROBE_P1X2 0
#define PROBE_SYNC 0

constexpr int DM = 1024, DEPTH = 4, INC = 9216;
constexpr int NP = 32768, NTOK = 98304;
constexpr int SP = 8192, SS = 4096;
constexpr int C_PZ = 512, C_Q = 1024, C_K = 2048, C_V = 3072, C_AZ = 4096, C_XQ = 5120, C_XZ = 5632, C_GL = 6144;
constexpr int MEMROWS = 20 * 256;
constexpr float ALPHA = 1.681792830507429f;
constexpr float LN_EPS = 1e-5f, SUBLN_EPS = 1e-5f;
constexpr int NWAVES = 8;

typedef unsigned short bf16_t;
typedef short bf16x8 __attribute__((ext_vector_type(8)));
typedef short s16x4 __attribute__((ext_vector_type(4)));
typedef float f32x4 __attribute__((ext_vector_type(4)));
typedef float f32x8 __attribute__((ext_vector_type(8)));
typedef float f32x16 __attribute__((ext_vector_type(16)));
typedef unsigned u32x4 __attribute__((ext_vector_type(4)));
typedef unsigned u32x2 __attribute__((ext_vector_type(2)));

constexpr size_t MiB = 1u << 20;
constexpr size_t WS_CTL = 0;
constexpr size_t WS_ROPE = 4096;
constexpr size_t WS_BAR = 768 * 1024, BAR_BYTES = 16384;
constexpr size_t WS_WIN = 1 * MiB;
constexpr size_t WS_WMEM = 73 * MiB;
constexpr size_t WS_WBA = 81 * MiB;
constexpr size_t WS_WBB = 85 * MiB;
constexpr size_t WS_WBC = 93 * MiB;
constexpr size_t WS_WOUT = 97 * MiB;
constexpr size_t WS_MEMB = 105 * MiB;
constexpr size_t WS_KVM = 115 * MiB;
constexpr size_t WS_XB = 155 * MiB;
constexpr size_t WS_H = 347 * MiB;

__device__ __forceinline__ unsigned cvt_pk_bf16(float lo, float hi) { unsigned r; asm volatile("v_cvt_pk_bf16_f32 %0, %1, %2" : "=v"(r) : "v"(lo), "v"(hi)); return r; }
__device__ __forceinline__ float bf_lo(unsigned u) { return __uint_as_float(u << 16); }
__device__ __forceinline__ float bf_hi(unsigned u) { return __uint_as_float(u & 0xffff0000u); }
__device__ __forceinline__ float bf2f(bf16_t v) { return __uint_as_float(((unsigned)v) << 16); }
__device__ __forceinline__ int opaque_tid() { int t = threadIdx.x; asm volatile("" : "+v"(t)); return t; }
__device__ __forceinline__ float sigmoidf_(float x) { return __builtin_amdgcn_rcpf(1.f + __expf(-x)); }

namespace pg8 {
#define PG8_LAS __attribute__((address_space(3)))
constexpr int BM = 256, BK = 64, HALF = 128, HTB = HALF * BK * 2, STAGE_BYTES = 8 * HTB, NXCD = 8, WGM = 8;

__host__ __device__ __forceinline__ int lds_byte(int r, int c) { const int st = (r >> 4) * 2 + (c >> 5), rr = r & 15, cc = c & 31, ob = rr * 64 + cc * 2; return st * 1024 + (ob ^ (((ob >> 9) & 1) << 5)); }
__host__ __device__ __forceinline__ void stage_rc(int b, int& R, int& C) { const int st = b / 1024, sb = b % 1024, swz = sb ^ (((sb >> 9) & 1) << 5); R = (st >> 1) * 16 + swz / 64; C = (st & 1) * 32 + (swz % 64) / 2; }
__host__ __device__ __forceinline__ int perm32(int rho) { const int n = rho >> 4, i = rho & 15; return 8 * (i >> 2) + 4 * n + (i & 3); }

struct Unit { int pm, pn, br; };
struct Gemm { const bf16_t* A; const bf16_t* Bt; int M, N, K, lda, ldb; };

struct StaticOrder {
    int nM, nN, nwg, G, c;
    __host__ __device__ void init(int M, int N, int G_, int c_) { nM = M / BM; nN = N / BM; nwg = nM * nN; G = G_; c = c_; }
    __host__ __device__ bool next(int i, Unit& u) const {
        const long L = (long)i * G + c; if (L >= nwg) return false;
        int wgid = (int)L; { const int q = nwg / NXCD, r = nwg % NXCD, xcd = wgid % NXCD, off = wgid / NXCD; wgid = (xcd < r ? xcd * (q + 1) : r * (q + 1) + (xcd - r) * q) + off; }
        const int nig = WGM * nN, gid = wgid / nig, fm = gid * WGM, gsz = (nM - fm) < WGM ? (nM - fm) : WGM;
        u.pm = fm + ((wgid % nig) % gsz); u.pn = (wgid % nig) / gsz; u.br = 0; return true;
    }
};
struct Order3 { StaticOrder base;
    __host__ __device__ bool next(int i, Unit& u) const { if (!base.next(i / 3, u)) return false; u.br = i % 3; return true; } };
#define PG8_EPI_DEFAULTS static constexpr bool SELFZERO = false; \
    __device__ static __forceinline__ size_t aoff(const Unit&) { return 0; } \
    __device__ static __forceinline__ size_t boff(const Unit&) { return 0; } \
    __device__ static __forceinline__ int nt(const Unit&, int ntdef) { return ntdef; }


struct EpiStore {
    static constexpr bool PERM = true; PG8_EPI_DEFAULTS
    bf16_t* O; int ldc;
    __device__ __forceinline__ void operator()(const f32x4 (&acc)[2][2][4][2], const Unit& u, int wr, int wc, int fr, int fq) const {
        const int row0 = u.pm * BM + wr * 64 + fr, col0 = u.pn * BM + wc * 32 + 8 * fq;
#pragma unroll
        for (int ai = 0; ai < 2; ++ai)
#pragma unroll
            for (int m = 0; m < 4; ++m) { bf16_t* rowp = O + (size_t)(row0 + ai * HALF + m * 16) * ldc + col0;
#pragma unroll
                for (int bj = 0; bj < 2; ++bj) { const f32x4 v0 = acc[ai][bj][m][0], v1 = acc[ai][bj][m][1];
                    u32x4 w; w.x = cvt_pk_bf16(v0[0], v0[1]); w.y = cvt_pk_bf16(v0[2], v0[3]); w.z = cvt_pk_bf16(v1[0], v1[1]); w.w = cvt_pk_bf16(v1[2], v1[3]);
                    *(u32x4*)(rowp + bj * HALF) = w; } }
    }
};
struct EpiIn {
    static constexpr bool PERM = true; PG8_EPI_DEFAULTS
    bf16_t* H; const float* rope; int row0g, smask;
    __device__ __forceinline__ void operator()(const f32x4 (&acc)[2][2][4][2], const Unit& u, int wr, int wc, int fr, int fq) const {
        const int row0 = u.pm * BM + wr * 64 + fr, colt = u.pn * BM, col0 = colt + wc * 32 + 8 * fq;
        const bool ropewave = (colt >= C_Q && colt < C_V) && ((wc & 1) == 0);
        const float qs = (colt >= C_Q && colt < C_K) ? 0.125f * 1.4426950408889634f : (colt >= C_XQ && colt < C_XZ) ? 0.088388347648318440f * 1.4426950408889634f : 1.f;
#pragma unroll
        for (int ai = 0; ai < 2; ++ai)
#pragma unroll
            for (int m = 0; m < 4; ++m) { const int row = row0 + ai * HALF + m * 16; bf16_t* rowp = H + (size_t)row * INC + col0;
                f32x4 c0 = {1.f, 1.f, 1.f, 1.f}, c1 = c0, s0 = {0.f, 0.f, 0.f, 0.f}, s1 = s0;
                if (ropewave && fq < 2) { const float* rp = rope + (size_t)((row0g + row) & smask) * 16;
                    c0 = *(const f32x4*)rp; c1 = *(const f32x4*)(rp + 4); s0 = *(const f32x4*)(rp + 8); s1 = *(const f32x4*)(rp + 12);
                    if (fq == 0) { s0 = -s0; s1 = -s1; } }
#pragma unroll
                for (int bj = 0; bj < 2; ++bj) { f32x4 v0 = acc[ai][bj][m][0], v1 = acc[ai][bj][m][1];
                    if (ropewave) { f32x4 p0, p1;
#pragma unroll
                        for (int e = 0; e < 4; ++e) { p0[e] = __shfl_xor(v0[e], 16); p1[e] = __shfl_xor(v1[e], 16); }
                        v0 = v0 * c0 + p0 * s0; v1 = v1 * c1 + p1 * s1; }
                    v0 = v0 * qs; v1 = v1 * qs;
                    if (colt >= C_GL) {
#pragma unroll
                        for (int e = 0; e < 4; ++e) { v0[e] = sigmoidf_(fmaxf(v0[e], -30.f)); v1[e] = sigmoidf_(fmaxf(v1[e], -30.f)); } }
                    u32x4 w; w.x = cvt_pk_bf16(v0[0], v0[1]); w.y = cvt_pk_bf16(v0[2], v0[3]); w.z = cvt_pk_bf16(v1[0], v1[1]); w.w = cvt_pk_bf16(v1[2], v1[3]);
                    *(u32x4*)(rowp + bj * HALF) = w; } }
    }
};
__device__ __forceinline__ float gclamp(float x) { return fminf(fmaxf(x, -30.f), 30.f); }
struct EpiBr3 {
    static constexpr bool PERM = true, SELFZERO = true;
    bf16_t* H;
    __device__ static __forceinline__ size_t aoff(const Unit& u) { return (size_t)(u.br == 0 ? C_PZ : u.br == 1 ? C_Q : C_XQ) * 2; }
    __device__ static __forceinline__ size_t boff(const Unit& u) { return (size_t)(u.br == 0 ? 0 : u.br == 1 ? 512 : 1536) * 2; }
    __device__ static __forceinline__ int nt(const Unit& u, int) { return u.br == 1 ? 16 : 8; }
    __device__ __forceinline__ void operator()(f32x4 (&acc)[2][2][4][2], const Unit& u, int wr, int wc, int fr, int fq) const {
        const int row0 = u.pm * BM + wr * 64 + fr, col0 = u.pn * BM + wc * 32 + 8 * fq;
        const int br = u.br;
#pragma unroll
        for (int ai = 0; ai < 2; ++ai)
#pragma unroll
            for (int m = 0; m < 4; ++m) { bf16_t* hrow = H + (size_t)(row0 + ai * HALF + m * 16) * INC;
#pragma unroll
                for (int bj = 0; bj < 2; ++bj) { const int col = col0 + bj * HALF;
                    if (br < 2) {
                        const u32x4 ga = *(const u32x4*)(hrow + C_GL + br * 1024 + col), gb = *(const u32x4*)(hrow + C_GL + (br + 1) * 1024 + col);
                        float r[8];
#pragma unroll
                        for (int e = 0; e < 4; ++e) { const unsigned wa = ga[e], wb = gb[e];
                            r[2 * e]     = bf_lo(wa) * __builtin_amdgcn_rcpf(bf_lo(wb));
                            r[2 * e + 1] = bf_hi(wa) * __builtin_amdgcn_rcpf(bf_hi(wb)); }
                        acc[ai][bj][m][0] *= (f32x4){r[0], r[1], r[2], r[3]}; acc[ai][bj][m][1] *= (f32x4){r[4], r[5], r[6], r[7]};
                    } else {
                        const u32x4 gc = *(const u32x4*)(hrow + C_GL + 2048 + col);
                        f32x4 g0, g1;
                        g0[0] = bf_lo(gc.x); g0[1] = bf_hi(gc.x); g0[2] = bf_lo(gc.y); g0[3] = bf_hi(gc.y);
                        g1[0] = bf_lo(gc.z); g1[1] = bf_hi(gc.z); g1[2] = bf_lo(gc.w); g1[3] = bf_hi(gc.w);
                        const f32x4 v0 = acc[ai][bj][m][0] * g0, v1 = acc[ai][bj][m][1] * g1;
                        u32x4 w; w.x = cvt_pk_bf16(v0[0], v0[1]); w.y = cvt_pk_bf16(v0[2], v0[3]); w.z = cvt_pk_bf16(v1[0], v1[1]); w.w = cvt_pk_bf16(v1[2], v1[3]);
                        *(u32x4*)(hrow + C_AZ + col) = w;
                        acc[ai][bj][m][0] = (f32x4){0.f, 0.f, 0.f, 0.f}; acc[ai][bj][m][1] = (f32x4){0.f, 0.f, 0.f, 0.f};
                    }
                    asm volatile("" ::: "memory"); } }
    }
};
struct EpiOut {
    static constexpr bool PERM = false; PG8_EPI_DEFAULTS
    const float* Yin; float* Yout; const float* stat; const float* g; const float* b;
    __device__ __forceinline__ void operator()(const f32x4 (&acc)[2][2][4][2], const Unit& u, int wr, int wc, int fr, int fq) const {
        const int row0 = u.pm * BM + wr * 64 + fr, col0 = u.pn * BM + wc * 32 + 4 * fq;
#pragma unroll
        for (int ai = 0; ai < 2; ++ai)
#pragma unroll
            for (int m = 0; m < 4; ++m) { const int r = row0 + ai * HALF + m * 16; const size_t off = (size_t)r * DM + col0;
                const float mu = stat[2 * r], rs = stat[2 * r + 1];
#pragma unroll
                for (int bj = 0; bj < 2; ++bj)
#pragma unroll
                    for (int n = 0; n < 2; ++n) { const int c = bj * HALF + n * 16; const f32x4 y = *(const f32x4*)(Yin + off + c);
                        const f32x4 gg = *(const f32x4*)(g + col0 + c), bb = *(const f32x4*)(b + col0 + c);
                        const f32x4 x = (y - mu) * rs * gg + bb;
                        *(f32x4*)(Yout + off + c) = x * ALPHA + acc[ai][bj][m][n]; }
                asm volatile("" ::: "memory"); }
    }
};

template <class Epi, class Sched, bool ALIGN_EPI = false, bool SP2 = false>
__device__ __forceinline__ void gemm_phase(PG8_LAS unsigned char* lds, const Gemm g, const Sched& S, const Epi& E) {
    const int tid = opaque_tid(), wid = __builtin_amdgcn_readfirstlane(tid >> 6), lane = tid & 63, wr = wid >> 2, wc = wid & 3, fr = lane & 15, fq = lane >> 4;
    const int K = g.K; int nt = K / BK;
    unsigned voffA[2], voffB[2];
#pragma unroll
    for (int i = 0; i < 2; ++i) { int R, C; stage_rc(tid * 16 + i * 8192, R, C); const int Rb = Epi::PERM ? ((R & ~31) + perm32(R & 31)) : R;
        voffA[i] = (unsigned)(R * g.lda + C) * 2u; voffB[i] = (unsigned)(Rb * g.ldb + C) * 2u; }
    const size_t kstep = (size_t)(BK * 2);
    const size_t hstepA = (size_t)HALF * g.lda * 2, hstepB = (size_t)HALF * g.ldb * 2;
    const size_t tstepA = 2 * hstepA, tstepB = 2 * hstepB;
    const unsigned ldsw = (unsigned)wid * 1024u;
    const int aoff = lds_byte(wr * 64 + fr, fq * 8), boff = lds_byte(wc * 32 + fr, fq * 8);
#define PG8_SA(b, h) (((b) * 2 + (h)) * HTB)
#define PG8_SB(b, h) ((4 + (b) * 2 + (h)) * HTB)
#define PG8_STAGE(bufoff, gbase, voff) do { _Pragma("unroll") for (int _i = 0; _i < 2; ++_i) \
        __builtin_amdgcn_global_load_lds((const unsigned*)((const char*)(gbase) + (voff)[_i]), (PG8_LAS unsigned*)(lds + (bufoff) + ldsw + _i * 8192), 16, 0, 0); } while (0)
#define PG8_LDA(dst, b, h) do { _Pragma("unroll") for (int m = 0; m < 4; ++m) _Pragma("unroll") for (int k = 0; k < 2; ++k) dst[m][k] = *(const PG8_LAS bf16x8*)(lds + PG8_SA(b, h) + aoff + m * 2048 + k * 1024); } while (0)
#define PG8_LDB(dst, b, h) do { _Pragma("unroll") for (int n = 0; n < 2; ++n) _Pragma("unroll") for (int k = 0; k < 2; ++k) dst[n][k] = *(const PG8_LAS bf16x8*)(lds + PG8_SB(b, h) + boff + n * 2048 + k * 1024); } while (0)
#define PG8_MMA(ai, bj, At, Bt) do { __builtin_amdgcn_s_setprio(1); _Pragma("unroll") for (int m = 0; m < 4; ++m) _Pragma("unroll") for (int n = 0; n < 2; ++n) _Pragma("unroll") for (int k = 0; k < 2; ++k) \
        acc[ai][bj][m][n] = __builtin_amdgcn_mfma_f32_16x16x32_bf16(Bt[n][k], At[m][k], acc[ai][bj][m][n], 0, 0, 0); __builtin_amdgcn_s_setprio(0); } while (0)
#define PG8_WAIT_V(n) asm volatile("s_waitcnt vmcnt(" #n ")" ::: "memory")
#define PG8_WAIT_L(n) asm volatile("s_waitcnt lgkmcnt(" #n ")" ::: "memory")
#define PG8_BAR __builtin_amdgcn_s_barrier()
#define PG8_SCHED __builtin_amdgcn_sched_barrier(0)
    Unit cur, nxt; int ui = 0;
    if (!S.next(0, cur)) return;
    f32x4 acc[2][2][4][2];
#pragma unroll
    for (int a = 0; a < 2; ++a)
#pragma unroll
        for (int b = 0; b < 2; ++b)
#pragma unroll
            for (int m = 0; m < 4; ++m)
#pragma unroll
                for (int n = 0; n < 2; ++n) acc[a][b][m][n] = (f32x4){0.f, 0.f, 0.f, 0.f};
    bf16x8 At[4][2], B0[2][2], B1[2][2];
    const char* cA = (const char*)g.A + (size_t)cur.pm * tstepA + Epi::aoff(cur); const char* cB = (const char*)g.Bt + (size_t)cur.pn * tstepB + Epi::boff(cur);
    nt = Epi::nt(cur, K / BK);
    if constexpr (SP2) {
        PG8_STAGE(PG8_SB(0, 0), cB, voffB); PG8_STAGE(PG8_SB(0, 1), cB + hstepB, voffB); PG8_STAGE(PG8_SA(0, 0), cA, voffA); PG8_STAGE(PG8_SA(0, 1), cA + hstepA, voffA);
        if (wr == 1) PG8_BAR;
        PG8_WAIT_V(2); PG8_BAR;
        PG8_STAGE(PG8_SB(1, 0), cB + kstep, voffB); PG8_STAGE(PG8_SA(1, 0), cA + kstep, voffA); PG8_STAGE(PG8_SB(1, 1), cB + hstepB + kstep, voffB);
        PG8_WAIT_V(6); PG8_BAR;
    } else {
        PG8_STAGE(PG8_SB(0, 0), cB, voffB); PG8_STAGE(PG8_SA(0, 0), cA, voffA); PG8_STAGE(PG8_SB(0, 1), cB + hstepB, voffB); PG8_STAGE(PG8_SA(0, 1), cA + hstepA, voffA);
        if (wr == 1) PG8_BAR;
        PG8_WAIT_V(4); PG8_BAR;
        PG8_STAGE(PG8_SB(1, 0), cB + kstep, voffB); PG8_STAGE(PG8_SA(1, 0), cA + kstep, voffA); PG8_STAGE(PG8_SB(1, 1), cB + hstepB + kstep, voffB);
        PG8_WAIT_V(6); PG8_BAR;
    }
    for (;;) {
        const bool has_next = S.next(ui + 1, nxt);
        const char* nA = has_next ? (const char*)g.A + (size_t)nxt.pm * tstepA + Epi::aoff(nxt) : cA; const char* nB = has_next ? (const char*)g.Bt + (size_t)nxt.pn * tstepB + Epi::boff(nxt) : cB;
        for (int t = 0; t < nt; t += 2) {
            const bool last = (t == nt - 2);
            const char* a1 = cA + (size_t)(t + 1) * kstep;
            const char* a2 = last ? nA : cA + (size_t)(t + 2) * kstep; const char* b2 = last ? nB : cB + (size_t)(t + 2) * kstep;
            const char* a3 = a2 + kstep; const char* b3 = b2 + kstep;
            if constexpr (SP2) {
            PG8_LDB(B0, 0, 0); PG8_LDB(B1, 0, 1); PG8_SCHED; PG8_LDA(At, 0, 0); PG8_STAGE(PG8_SA(1, 1), a1 + hstepA, voffA);
            PG8_WAIT_V(8); PG8_WAIT_L(0); PG8_BAR; PG8_MMA(0, 0, At, B0); PG8_MMA(0, 1, At, B1); PG8_BAR; PG8_SCHED;
            PG8_LDA(At, 0, 1); PG8_STAGE(PG8_SB(0, 0), b2, voffB); PG8_STAGE(PG8_SB(0, 1), b2 + hstepB, voffB); PG8_STAGE(PG8_SA(0, 0), a2, voffA);
            PG8_WAIT_V(8); PG8_WAIT_L(0); PG8_BAR; PG8_MMA(1, 0, At, B0); PG8_MMA(1, 1, At, B1); PG8_BAR; PG8_SCHED;
            PG8_LDB(B0, 1, 0); PG8_LDB(B1, 1, 1); PG8_SCHED; PG8_LDA(At, 1, 0); PG8_STAGE(PG8_SA(0, 1), a2 + hstepA, voffA);
            PG8_WAIT_V(8); PG8_WAIT_L(0); PG8_BAR; PG8_MMA(0, 0, At, B0); PG8_MMA(0, 1, At, B1); PG8_BAR; PG8_SCHED;
            PG8_LDA(At, 1, 1); PG8_STAGE(PG8_SB(1, 0), b3, voffB); PG8_STAGE(PG8_SB(1, 1), b3 + hstepB, voffB); PG8_STAGE(PG8_SA(1, 0), a3, voffA);
            PG8_WAIT_V(8); PG8_WAIT_L(0); PG8_BAR; PG8_MMA(1, 0, At, B0); PG8_MMA(1, 1, At, B1); PG8_BAR; PG8_SCHED;
            } else {
            PG8_LDB(B0, 0, 0); PG8_SCHED; PG8_LDA(At, 0, 0); PG8_STAGE(PG8_SA(1, 1), a1 + hstepA, voffA);
            PG8_WAIT_L(8); PG8_BAR; PG8_WAIT_L(0); PG8_MMA(0, 0, At, B0); PG8_BAR; PG8_SCHED;
            PG8_LDB(B1, 0, 1); PG8_STAGE(PG8_SB(0, 0), b2, voffB);
            PG8_BAR; PG8_WAIT_L(0); PG8_MMA(0, 1, At, B1); PG8_BAR;
            PG8_LDA(At, 0, 1); PG8_STAGE(PG8_SA(0, 0), a2, voffA);
            PG8_BAR; PG8_WAIT_L(0); PG8_MMA(1, 0, At, B0); PG8_BAR; PG8_SCHED;
            PG8_STAGE(PG8_SB(0, 1), b2 + hstepB, voffB);
            PG8_WAIT_V(6); PG8_BAR; PG8_MMA(1, 1, At, B1); PG8_BAR;
            PG8_LDB(B0, 1, 0); PG8_SCHED; PG8_LDA(At, 1, 0); PG8_STAGE(PG8_SA(0, 1), a2 + hstepA, voffA);
            PG8_WAIT_L(8); PG8_BAR; PG8_WAIT_L(0); PG8_MMA(0, 0, At, B0); PG8_BAR; PG8_SCHED;
            PG8_LDB(B1, 1, 1); PG8_STAGE(PG8_SB(1, 0), b3, voffB);
            PG8_BAR; PG8_WAIT_L(0); PG8_MMA(0, 1, At, B1); PG8_BAR;
            PG8_LDA(At, 1, 1); PG8_STAGE(PG8_SA(1, 0), a3, voffA);
            PG8_BAR; PG8_WAIT_L(0); PG8_MMA(1, 0, At, B0); PG8_BAR; PG8_SCHED;
            PG8_STAGE(PG8_SB(1, 1), b3 + hstepB, voffB);
            PG8_WAIT_V(6); PG8_BAR; PG8_MMA(1, 1, At, B1); PG8_BAR;
            }
        }
        if constexpr (ALIGN_EPI) { if (wr == 0) PG8_BAR; }
        E(acc, cur, wr, wc, fr, fq);
        if (!has_next) break;
        if constexpr (!Epi::SELFZERO) {
#pragma unroll
        for (int a = 0; a < 2; ++a)
#pragma unroll
            for (int b = 0; b < 2; ++b)
#pragma unroll
                for (int m = 0; m < 4; ++m)
#pragma unroll
                    for (int n = 0; n < 2; ++n) acc[a][b][m][n] = (f32x4){0.f, 0.f, 0.f, 0.f};
        }
        cur = nxt; cA = nA; cB = nB; ++ui; nt = Epi::nt(cur, K / BK);
        if constexpr (ALIGN_EPI) { if (wr == 1) PG8_BAR; }
    }
    PG8_WAIT_V(0);
    if constexpr (!ALIGN_EPI) { if (wr == 0) PG8_BAR; }
    PG8_BAR;
#undef PG8_SA
#undef PG8_SB
#undef PG8_STAGE
#undef PG8_LDA
#undef PG8_LDB
#undef PG8_MMA
#undef PG8_WAIT_V
#undef PG8_WAIT_L
#undef PG8_BAR
#undef PG8_SCHED
}
}

namespace att {
constexpr int D = 128, QBLK = 32, KVBLK = 64;
constexpr float THR = 8.f;
constexpr int NBUF = 3;
constexpr size_t SHM_V = KVBLK * D * 2, SHM_K = KVBLK * D * 2, SHM_ATTN = NBUF * SHM_V + NBUF * SHM_K + NWAVES * 64 * 4;
#define KSWZ(row, colB) ((row) * 256 + ((colB) ^ (((row) & 7) << 4)))
#define SBAR() __builtin_amdgcn_sched_barrier(0)
__device__ __forceinline__ int crow(int r, int hi) { return (r & 3) + 8 * (r >> 2) + 4 * hi; }
__device__ __forceinline__ bf16x8 ld8(const bf16_t* p) { return *reinterpret_cast<const bf16x8*>(p); }

__device__ __forceinline__ void partialSM(f32x16& p0, f32x16& p1, float& m_reg, float& alpha) {
  constexpr float THR2 = THR * 1.4426950408889634f;
  float pmax = p0[0];
#pragma unroll
  for (int r = 1; r < 16; ++r) pmax = fmaxf(pmax, p0[r]);
#pragma unroll
  for (int r = 0; r < 16; ++r) pmax = fmaxf(pmax, p1[r]);
  { auto rr = __builtin_amdgcn_permlane32_swap(__float_as_uint(pmax), __float_as_uint(pmax), false, false);
    pmax = fmaxf(__uint_as_float(rr[0]), __uint_as_float(rr[1])); }
  float mn;
  if (__builtin_expect(__all(pmax - m_reg <= THR2), 1)) { mn = m_reg; alpha = 1.f; }
  else { mn = fmaxf(m_reg, pmax); alpha = __builtin_amdgcn_exp2f(m_reg - mn); m_reg = mn; }
#pragma unroll
  for (int r = 0; r < 16; ++r) { p0[r] -= mn; p1[r] -= mn; }
#pragma unroll
  for (int r = 0; r < 16; ++r) p0[r] = __builtin_amdgcn_exp2f(p0[r]);
}
__device__ __forceinline__ void finishSM(f32x16& p0, f32x16& p1, float alpha, float& l_reg, bf16x8& pa0, bf16x8& pa1, bf16x8& pa2, bf16x8& pa3) {
#pragma unroll
  for (int r = 0; r < 16; ++r) p1[r] = __builtin_amdgcn_exp2f(p1[r]);
  float ps = 0;
#pragma unroll
  for (int r = 0; r < 16; ++r) ps += p0[r];
#pragma unroll
  for (int r = 0; r < 16; ++r) ps += p1[r];
  { auto rr = __builtin_amdgcn_permlane32_swap(__float_as_uint(ps), __float_as_uint(ps), false, false);
    ps = __uint_as_float(rr[0]) + __uint_as_float(rr[1]); }
  l_reg = l_reg * alpha + ps;
#define PK4(P, BASE, OUT) do { unsigned a0 = cvt_pk_bf16(P[BASE + 0], P[BASE + 1]), a1 = cvt_pk_bf16(P[BASE + 2], P[BASE + 3]);   \
    unsigned b0 = cvt_pk_bf16(P[BASE + 4], P[BASE + 5]), b1 = cvt_pk_bf16(P[BASE + 6], P[BASE + 7]);                              \
    auto r0 = __builtin_amdgcn_permlane32_swap(a0, b0, false, false); auto r1 = __builtin_amdgcn_permlane32_swap(a1, b1, false, false); \
    u32x4 w = {r0[0], r1[0], r0[1], r1[1]}; OUT = *reinterpret_cast<bf16x8*>(&w); } while (0)
  PK4(p0, 0, pa0); PK4(p0, 8, pa1); PK4(p1, 0, pa2); PK4(p1, 8, pa3);
#undef PK4
}
template <int NQ, bool QREG> __device__ __forceinline__ void qkt(f32x16& p0, f32x16& p1, const bf16_t* Ks, const bf16x8* qr, const bf16_t* Qw, int r32, int hi, int qcolB) {
  p0 = f32x16{}; p1 = f32x16{};
#pragma unroll
  for (int d0 = 0; d0 < NQ; ++d0) { int cb = qcolB + (d0 * 16 + hi * 8) * 2;
    bf16x8 b0 = *reinterpret_cast<const bf16x8*>((const char*)Ks + KSWZ(r32, cb));
    bf16x8 b1 = *reinterpret_cast<const bf16x8*>((const char*)Ks + KSWZ(32 + r32, cb));
    const bf16x8 qv = QREG ? qr[d0] : ld8(Qw + d0 * 16);
    p0 = __builtin_amdgcn_mfma_f32_32x32x16_bf16(b0, qv, p0, 0, 0, 0); p1 = __builtin_amdgcn_mfma_f32_32x32x16_bf16(b1, qv, p1, 0, 0, 0); }
  if (QREG) { __builtin_amdgcn_sched_group_barrier(0x100, 2 * NQ, 0); __builtin_amdgcn_sched_group_barrier(0x008, 2 * NQ, 0); }
}
template <int NQ> __device__ __forceinline__ void kload(bf16x8 (&kf)[2 * NQ], const bf16_t* Ks, int r32, int hi, int qcolB) {
#pragma unroll
  for (int d0 = 0; d0 < NQ; ++d0) { int cb = qcolB + (d0 * 16 + hi * 8) * 2;
    kf[2 * d0] = *reinterpret_cast<const bf16x8*>((const char*)Ks + KSWZ(r32, cb)); kf[2 * d0 + 1] = *reinterpret_cast<const bf16x8*>((const char*)Ks + KSWZ(32 + r32, cb)); }
}
template <int NQ> __device__ __forceinline__ void kmfma(f32x16& p0, f32x16& p1, const bf16x8 (&kf)[2 * NQ], const bf16x8* qr) {
  p0 = f32x16{}; p1 = f32x16{};
#pragma unroll
  for (int d0 = 0; d0 < NQ; ++d0) { p0 = __builtin_amdgcn_mfma_f32_32x32x16_bf16(kf[2 * d0], qr[d0], p0, 0, 0, 0); p1 = __builtin_amdgcn_mfma_f32_32x32x16_bf16(kf[2 * d0 + 1], qr[d0], p1, 0, 0, 0); }
}
__device__ __forceinline__ int v_st(int k, int c) { const int kk = (k & ~0xC) | ((k & 4) << 1) | ((k & 8) >> 1); return ((kk >> 3) * 4 + (c >> 5)) * 512 + ((kk & 7) * 32 + (c & 31)) * 2; }
__device__ __forceinline__ int v_rd_base(int lane) { return ((lane & 3) << 3) | (((lane >> 2) & 3) << 6) | (((lane >> 4) & 1) << 5) | (((lane >> 5) & 1) << 8); }
constexpr int v_rd_off(int d0, int ks, int half) { return d0 * 512 + ks * 4096 + half * 2048; }
typedef __attribute__((address_space(3))) const char* lds_cptr;
typedef short v4i16_t __attribute__((ext_vector_type(4)));
__device__ __forceinline__ s16x4 vtr(lds_cptr p) { return __builtin_bit_cast(s16x4, __builtin_amdgcn_ds_read_tr16_b64_v4i16((__attribute__((address_space(3))) v4i16_t*)p)); }
#define VRDK(L, H, KS) do { _Pragma("unroll") for (int d0 = 0; d0 < 4; ++d0) { L[d0] = vtr(vp + v_rd_off(d0, KS, 0)); H[d0] = vtr(vp + v_rd_off(d0, KS, 1)); } } while (0)
#define PK(L, H) (bf16x8){L[0], L[1], L[2], L[3], H[0], H[1], H[2], H[3]}
#define PVK(pa, L, H) do { _Pragma("unroll") for (int d0 = 0; d0 < 4; ++d0) o[d0] = __builtin_amdgcn_mfma_f32_32x32x16_bf16(pa, PK(L[d0], H[d0]), o[d0], 0, 0, 0); } while (0)
template <bool PIPE> __device__ __forceinline__ void pv_d0(f32x16* o, lds_cptr vp, bf16x8 pa0, bf16x8 pa1, bf16x8 pa2, bf16x8 pa3) {
  s16x4 La[4], Ha[4], Lb[4], Hb[4];
  if constexpr (!PIPE) {
    VRDK(La, Ha, 0); PVK(pa0, La, Ha); VRDK(La, Ha, 1); PVK(pa1, La, Ha); VRDK(La, Ha, 2); PVK(pa2, La, Ha); VRDK(La, Ha, 3); PVK(pa3, La, Ha);
    return;
  }
  VRDK(La, Ha, 0); VRDK(Lb, Hb, 1);
  PVK(pa0, La, Ha); VRDK(La, Ha, 2);
  PVK(pa1, Lb, Hb); VRDK(Lb, Hb, 3);
  PVK(pa2, La, Ha); PVK(pa3, Lb, Hb);
  __builtin_amdgcn_sched_group_barrier(0x100, 16, 0); __builtin_amdgcn_sched_group_barrier(0x008, 4, 0);
  __builtin_amdgcn_sched_group_barrier(0x100, 8, 0);  __builtin_amdgcn_sched_group_barrier(0x008, 4, 0);
  __builtin_amdgcn_sched_group_barrier(0x100, 8, 0);  __builtin_amdgcn_sched_group_barrier(0x008, 8, 0);
}
__device__ __forceinline__ void pv_pref(s16x4 (&La)[4], s16x4 (&Ha)[4], s16x4 (&Lb)[4], s16x4 (&Hb)[4], lds_cptr vp) { VRDK(La, Ha, 0); }
__device__ __forceinline__ void pv_rest(f32x16* o, s16x4 (&La)[4], s16x4 (&Ha)[4], s16x4 (&Lb)[4], s16x4 (&Hb)[4], lds_cptr vp, bf16x8 pa0, bf16x8 pa1, bf16x8 pa2, bf16x8 pa3) {
  VRDK(Lb, Hb, 1);
  PVK(pa0, La, Ha); VRDK(La, Ha, 2);
  PVK(pa1, Lb, Hb); VRDK(Lb, Hb, 3);
  PVK(pa2, La, Ha); PVK(pa3, Lb, Hb);
  __builtin_amdgcn_sched_group_barrier(0x100, 8, 0); __builtin_amdgcn_sched_group_barrier(0x008, 4, 0); __builtin_amdgcn_sched_group_barrier(0x100, 8, 0);  __builtin_amdgcn_sched_group_barrier(0x008, 4, 0);
  __builtin_amdgcn_sched_group_barrier(0x100, 8, 0);  __builtin_amdgcn_sched_group_barrier(0x008, 8, 0);
}
#undef VRDK
#undef PK
#undef PVK

__device__ __forceinline__ void store_gated(const f32x16* v, float* stg, bf16_t* out, const bf16_t* gate, int lane, int r32, int hi, bool write) {
#pragma unroll
  for (int d0 = 0; d0 < 4; ++d0)
#pragma unroll
    for (int r = 0; r < 16; ++r) stg[crow(r, hi) * 128 + d0 * 32 + r32] = v[d0][r];
  asm volatile("s_waitcnt lgkmcnt(0)" ::: "memory");
#pragma unroll
  for (int it = 0; it < 8; ++it) {
    const int row = it * 4 + (lane >> 4), c8 = (lane & 15) * 8;
    const f32x4 a = *(const f32x4*)(stg + row * 128 + c8), b = *(const f32x4*)(stg + row * 128 + c8 + 4);
    const u32x4 g = *(const u32x4*)(gate + (long)row * INC + c8);
    float z[8] = {bf_lo(g.x), bf_hi(g.x), bf_lo(g.y), bf_hi(g.y), bf_lo(g.z), bf_hi(g.z), bf_lo(g.w), bf_hi(g.w)};
    float y[8];
#pragma unroll
    for (int e = 0; e < 8; ++e) y[e] = (e < 4 ? a[e] : b[e - 4]) * z[e] * sigmoidf_(z[e]);
    u32x4 w; w.x = cvt_pk_bf16(y[0], y[1]); w.y = cvt_pk_bf16(y[2], y[3]); w.z = cvt_pk_bf16(y[4], y[5]); w.w = cvt_pk_bf16(y[6], y[7]);
    if (write) *(u32x4*)(out + (long)row * INC + c8) = w; else if (y[0] == 123.456f) out[0] = 0;
  }
}

__device__ __forceinline__ void store_gated_half(const float (&w)[4][8], float* stg, bf16_t* out, u32x4 g0_, u32x4 g1_, u32x4 g2_, u32x4 g3_, int lane, int r32, int hi, bool write) {
#pragma unroll
  for (int d0 = 0; d0 < 4; ++d0)
#pragma unroll
    for (int q = 0; q < 8; ++q) stg[crow(q, hi) * 128 + d0 * 32 + r32] = w[d0][q];
  asm volatile("s_waitcnt lgkmcnt(0)" ::: "memory");
#pragma unroll
  for (int it = 0; it < 4; ++it) {
    const int row = it * 4 + (lane >> 4), c8 = (lane & 15) * 8;
    const f32x4 a = *(const f32x4*)(stg + row * 128 + c8), b = *(const f32x4*)(stg + row * 128 + c8 + 4);
    const u32x4 g = (it == 0) ? g0_ : (it == 1) ? g1_ : (it == 2) ? g2_ : g3_;
    float z[8] = {bf_lo(g.x), bf_hi(g.x), bf_lo(g.y), bf_hi(g.y), bf_lo(g.z), bf_hi(g.z), bf_lo(g.w), bf_hi(g.w)};
    float y[8];
#pragma unroll
    for (int e = 0; e < 8; ++e) y[e] = (e < 4 ? a[e] : b[e - 4]) * z[e] * sigmoidf_(z[e]);
    u32x4 wv; wv.x = cvt_pk_bf16(y[0], y[1]); wv.y = cvt_pk_bf16(y[2], y[3]); wv.z = cvt_pk_bf16(y[4], y[5]); wv.w = cvt_pk_bf16(y[6], y[7]);
    if (write) *(u32x4*)(out + (long)row * INC + c8) = wv; else if (y[0] == 123.456f) out[0] = 0;
  }
}

struct Stg { bf16x8 vs0, vs1, ks0, ks1; };
struct Pre { bf16x8 q0, q1, q2, q3, vs0, vs1, ks0, ks1, vb0, vb1, kb0, kb1; };
__device__ __forceinline__ Pre pre_zero() { Pre p; const bf16x8 z_ = {}; p.q0 = z_; p.q1 = z_; p.q2 = z_; p.q3 = z_; p.vs0 = z_; p.vs1 = z_; p.ks0 = z_; p.ks1 = z_; p.vb0 = z_; p.vb1 = z_; p.kb0 = z_; p.kb1 = z_; return p; }
template <int MODE, bool WRITE = true>
__device__ __forceinline__ Pre attn_unit(bf16_t* Qb, const bf16_t* __restrict__ Kh, const bf16_t* __restrict__ Vh, const bf16_t* Gz,
                                          int seq, char* lds, const float* subg, float lam, float oscale,
                                          const Pre pin, bool have_pre, const bf16_t* Hb, int qoff_next, int kvoff_next) {
  Pre pout = pre_zero();
  constexpr int LDQ = INC, LDK = MODE == 0 ? INC : 4096, NQ = MODE == 0 ? 4 : 8;
  const int tid = opaque_tid(), wid = __builtin_amdgcn_readfirstlane(tid >> 6), lane = tid & 63, r32 = lane & 31, hi = lane >> 5;
  const int rg = MODE == 0 ? (wid & 3) : wid, comp = MODE == 0 ? (wid >> 2) : 0;
  bf16_t* V_lds = (bf16_t*)lds; bf16_t* K_lds = (bf16_t*)(lds + NBUF * SHM_V);
  float* ws = (float*)(lds + NBUF * SHM_V + NBUF * SHM_K) + wid * 64; float* li_l = ws; float* al_l = ws + 32;
  float m_run = -1e30f, l_reg = 0.f; f32x16 o[4] = {}; bf16x8 qr[NQ];
  const bf16_t* Qw = Qb + (long)(rg * QBLK + r32) * LDQ + comp * 64 + hi * 8;
  const int qcolB = comp * 128;
#pragma unroll
  for (int d0 = 0; d0 < NQ; ++d0) qr[d0] = bf16x8{};
  if (MODE == 0 && have_pre) { qr[0] = pin.q0; qr[1] = pin.q1; qr[2] = pin.q2; qr[3] = pin.q3; }
  else {
#pragma unroll
    for (int d0 = 0; d0 < NQ; ++d0) qr[d0] = ld8(Qw + d0 * 16); }
  const int sr = tid >> 4, sc = (tid & 15) * 8, vst0 = v_st(sr, sc), vst1 = v_st(32 + sr, sc);
  const lds_cptr vb0 = (lds_cptr)lds + v_rd_base(lane);
  Stg stA, stB;
  const int soff0 = sr * LDK + sc, soff1 = soff0 + 32 * LDK;
#define SLOAD(S, k0) do { const bf16_t* vt_ = Vh + (long)(k0) * LDK; const bf16_t* kt_ = Kh + (long)(k0) * LDK; \
    S.vs0 = ld8(vt_ + soff0); S.vs1 = ld8(vt_ + soff1); S.ks0 = ld8(kt_ + soff0); S.ks1 = ld8(kt_ + soff1); } while (0)
#define SWRITE(S, b) do { *(bf16x8*)((char*)V_lds + (b) * SHM_V + vst0) = S.vs0;          \
    *(bf16x8*)((char*)V_lds + (b) * SHM_V + vst1) = S.vs1; int kc = sc * 2;               \
    *(bf16x8*)((char*)K_lds + (b) * SHM_K + KSWZ(sr, kc)) = S.ks0;                       \
    *(bf16x8*)((char*)K_lds + (b) * SHM_K + KSWZ(32 + sr, kc)) = S.ks1; } while (0)
#define RESC(a) do { if (__any((a) < 1.f)) { if (hi == 0) al_l[r32] = (a); asm volatile("s_waitcnt lgkmcnt(0)" ::: "memory"); \
    _Pragma("unroll") for (int r = 0; r < 16; ++r) { const float a_ = al_l[crow(r, hi)]; _Pragma("unroll") for (int d = 0; d < 4; ++d) o[d][r] *= a_; } } } while (0)
  const int grp = wid >> 2;
  f32x16 p0, p1; float al; bf16x8 pa0, pa1, pa2, pa3; const int NT = seq / KVBLK;
  if (MODE == 0 && have_pre) { stA.vs0 = pin.vs0; stA.vs1 = pin.vs1; stA.ks0 = pin.ks0; stA.ks1 = pin.ks1; } else { SLOAD(stA, 0); }
  asm volatile("s_waitcnt vmcnt(0)" ::: "memory"); SWRITE(stA, 0);
  if constexpr (MODE == 0) { if (have_pre) { stB.vs0 = pin.vb0; stB.vs1 = pin.vb1; stB.ks0 = pin.kb0; stB.ks1 = pin.kb1; } else { SLOAD(stB, KVBLK); } if (2 < NT) SLOAD(stA, 2 * KVBLK); } else { SLOAD(stA, KVBLK); }
  __syncthreads();
#define WGBAR() asm volatile("s_waitcnt lgkmcnt(0)\n\ts_barrier" ::: "memory")
#define ROT() do { const int t_ = bprv; bprv = bcur; bcur = bnxt; bnxt = t_; } while (0)
#define MID(S, j) do { SBAR(); if ((j) + 1 < NT) { SWRITE(S, bnxt); } if ((j) + (MODE == 0 ? 3 : 2) < NT) SLOAD(S, ((j) + (MODE == 0 ? 3 : 2)) * KVBLK); SBAR(); } while (0)
#define IV0(S, j) do { const bf16_t* Kc = (const bf16_t*)((const char*)K_lds + bcur * SHM_K); const lds_cptr vbp = vb0 + bprv * (int)SHM_V; \
      SBAR(); __builtin_amdgcn_s_setprio(1); qkt<NQ, true>(p0, p1, Kc, qr, Qw, r32, hi, qcolB); \
      if ((j) > 0) pv_d0<MODE == 0>(o, vbp, pa0, pa1, pa2, pa3); \
      __builtin_amdgcn_s_setprio(0); MID(S, j); \
      partialSM(p0, p1, m_run, al); RESC(al); finishSM(p0, p1, al, l_reg, pa0, pa1, pa2, pa3); SBAR(); \
      WGBAR(); ROT(); } while (0)
#define IV1(S, j) do { const bf16_t* Kc = (const bf16_t*)((const char*)K_lds + bcur * SHM_K); const lds_cptr vbp = vb0 + bprv * (int)SHM_V; \
      if ((j) > 0) { SBAR(); partialSM(p0, p1, m_run, al); RESC(al); finishSM(p0, p1, al, l_reg, pa0, pa1, pa2, pa3); } \
      MID(S, j); \
      __builtin_amdgcn_s_setprio(1); if ((j) > 0) pv_d0<MODE == 0>(o, vbp, pa0, pa1, pa2, pa3); \
      SBAR(); qkt<NQ, true>(p0, p1, Kc, qr, Qw, r32, hi, qcolB); __builtin_amdgcn_s_setprio(0); SBAR(); \
      WGBAR(); ROT(); } while (0)
  int bprv = 2, bcur = 0, bnxt = 1;
  if constexpr (MODE == 0) {
#define JV0(S, j) do { const bf16_t* Kc = (const bf16_t*)((const char*)K_lds + bcur * SHM_K); const lds_cptr vbp = vb0 + bprv * (int)SHM_V; \
      SBAR(); __builtin_amdgcn_s_setprio(1); \
      if ((j) > 0) pv_d0<true>(o, vbp, pa0, pa1, pa2, pa3); \
      SBAR(); qkt<NQ, true>(p0, p1, Kc, qr, Qw, r32, hi, qcolB); __builtin_amdgcn_s_setprio(0); MID(S, j); \
      partialSM(p0, p1, m_run, al); RESC(al); finishSM(p0, p1, al, l_reg, pa0, pa1, pa2, pa3); SBAR(); \
      WGBAR(); ROT(); } while (0)
#define JV1(S, j) do { const bf16_t* Kc = (const bf16_t*)((const char*)K_lds + bcur * SHM_K); const lds_cptr vbp = vb0 + bprv * (int)SHM_V; \
      if ((j) > 0) { SBAR(); partialSM(p0, p1, m_run, al); RESC(al); finishSM(p0, p1, al, l_reg, pa0, pa1, pa2, pa3); } \
      MID(S, j); \
      __builtin_amdgcn_s_setprio(1); if ((j) > 0) pv_d0<true>(o, vbp, pa0, pa1, pa2, pa3); \
      SBAR(); qkt<NQ, true>(p0, p1, Kc, qr, Qw, r32, hi, qcolB); __builtin_amdgcn_s_setprio(0); SBAR(); \
      WGBAR(); ROT(); } while (0)
    if (grp == 0) {
      for (int j = 0; j < NT; j += 2) { JV0(stB, j); JV0(stA, j + 1); }
      SBAR(); pv_d0<true>(o, vb0 + bprv * (int)SHM_V, pa0, pa1, pa2, pa3);
    } else {
      for (int j = 0; j < NT; j += 2) { JV1(stB, j); JV1(stA, j + 1); }
      SBAR(); partialSM(p0, p1, m_run, al); RESC(al); finishSM(p0, p1, al, l_reg, pa0, pa1, pa2, pa3); SBAR();
      pv_d0<true>(o, vb0 + bprv * (int)SHM_V, pa0, pa1, pa2, pa3);
    }
#undef JV0
#undef JV1
  } else {
  if (grp == 0) {
    for (int j = 0; j < NT; j += 2) { IV0(stA, j); IV0(stA, j + 1); }
  } else {
    for (int j = 0; j < NT; j += 2) { IV1(stA, j); IV1(stA, j + 1); }
    SBAR(); partialSM(p0, p1, m_run, al); RESC(al); finishSM(p0, p1, al, l_reg, pa0, pa1, pa2, pa3); SBAR();
  }
  pv_d0<MODE == 0>(o, vb0 + bprv * (int)SHM_V, pa0, pa1, pa2, pa3);
  }
#undef WGBAR
#undef ROT
#undef MID
#undef IV0
#undef IV1
  if (hi == 0) li_l[r32] = l_reg; asm volatile("s_waitcnt lgkmcnt(0)" ::: "memory");
  float rli[16];
#pragma unroll
  for (int r = 0; r < 16; ++r) rli[r] = __builtin_amdgcn_rcpf(li_l[crow(r, hi)]);
#pragma unroll
  for (int d0 = 0; d0 < 4; ++d0)
#pragma unroll
    for (int r = 0; r < 16; ++r) o[d0][r] *= rli[r];
  if constexpr (MODE == 0) {
    u32x4 gq0, gq1, gq2, gq3;
    { const bf16_t* gw_ = Gz + (long)(rg * QBLK + comp * 16 + (lane >> 4)) * INC + (lane & 15) * 8;
      gq0 = *(const u32x4*)gw_; gq1 = *(const u32x4*)(gw_ + 4 * INC); gq2 = *(const u32x4*)(gw_ + 8 * INC); gq3 = *(const u32x4*)(gw_ + 12 * INC); }
    __syncthreads();
    float* xw = (float*)lds + wid * 2048 + lane; const float* xr = (const float*)lds + (wid ^ 4) * 2048 + lane;
#pragma unroll
    for (int d0 = 0; d0 < 4; ++d0)
#pragma unroll
      for (int q = 0; q < 8; ++q) xw[(d0 * 8 + q) * 64] = (comp == 0) ? o[d0][8 + q] : o[d0][q];
    __syncthreads();
    float w[4][8];
#pragma unroll
    for (int d0 = 0; d0 < 4; ++d0)
#pragma unroll
      for (int q = 0; q < 8; ++q) { const float x = xr[(d0 * 8 + q) * 64]; w[d0][q] = (comp == 0) ? (o[d0][q] - lam * x) : (x - lam * o[d0][8 + q]); }
    if (qoff_next >= 0) {
      const bf16_t* Qwn = Hb + qoff_next + (long)(rg * QBLK + r32) * LDQ + comp * 64 + hi * 8; const bf16_t* Kh_next = Hb + kvoff_next + C_K; const bf16_t* Vh_next = Hb + kvoff_next + C_V;
      pout.q0 = ld8(Qwn); pout.q1 = ld8(Qwn + 16); pout.q2 = ld8(Qwn + 32); pout.q3 = ld8(Qwn + 48);
      pout.vs0 = ld8(Vh_next + soff0); pout.vs1 = ld8(Vh_next + soff1); pout.ks0 = ld8(Kh_next + soff0); pout.ks1 = ld8(Kh_next + soff1);
      pout.vb0 = ld8(Vh_next + KVBLK * LDK + soff0); pout.vb1 = ld8(Vh_next + KVBLK * LDK + soff1); pout.kb0 = ld8(Kh_next + KVBLK * LDK + soff0); pout.kb1 = ld8(Kh_next + KVBLK * LDK + soff1);
    }
    float g4[4];
#pragma unroll
    for (int d0 = 0; d0 < 4; ++d0) g4[d0] = subg[d0 * 32 + r32] * oscale;
#pragma unroll
    for (int q = 0; q < 8; ++q) {
      float ss = w[0][q] * w[0][q] + w[1][q] * w[1][q] + w[2][q] * w[2][q] + w[3][q] * w[3][q];
      ss += __shfl_xor(ss, 1); ss += __shfl_xor(ss, 2); ss += __shfl_xor(ss, 4); ss += __shfl_xor(ss, 8); ss += __shfl_xor(ss, 16);
      const float rs = __builtin_amdgcn_rsqf(ss * (1.f / 128.f) + SUBLN_EPS);
#pragma unroll
      for (int d0 = 0; d0 < 4; ++d0) w[d0][q] *= rs * g4[d0];
    }
    store_gated_half(w, (float*)lds + 16384 + wid * 2048, Qb + (long)(rg * QBLK + comp * 16) * INC, gq0, gq1, gq2, gq3, lane, r32, hi, WRITE);
  } else {
    __syncthreads();
    store_gated(o, (float*)lds + wid * 4096, Qb + (long)(rg * QBLK) * INC, Gz + (long)(rg * QBLK) * INC, lane, r32, hi, WRITE);
  }
  __syncthreads();
  return pout;
#undef SLOAD
#undef SWRITE
#undef RESC
}
#undef KSWZ
#undef SBAR
}

__device__ __forceinline__ float wave_sum(float v) {
#pragma unroll
    for (int o = 1; o < 64; o <<= 1) v += __shfl_xor(v, o);
    return v;
}
__device__ __forceinline__ void transpose_item(const float* W, int K, int N, bf16_t* WT, int ldt, float* scr, int kb, int nb, int lane) {
    const int k0 = 64 * kb, n0 = 32 * nb;
#pragma unroll 8
    for (int i = 0; i < 32; ++i) { const int kk = 2 * i + (lane >> 5); scr[kk * 33 + (lane & 31)] = W[(size_t)(k0 + kk) * N + n0 + (lane & 31)]; }
    asm volatile("s_waitcnt lgkmcnt(0)" ::: "memory");
    const int c = lane & 7;
#pragma unroll
    for (int j = 0; j < 4; ++j) { const int n = (lane >> 3) + 8 * j; const float* s = scr + (8 * c) * 33 + n;
        u32x4 o; o.x = cvt_pk_bf16(s[0 * 33], s[1 * 33]); o.y = cvt_pk_bf16(s[2 * 33], s[3 * 33]); o.z = cvt_pk_bf16(s[4 * 33], s[5 * 33]); o.w = cvt_pk_bf16(s[6 * 33], s[7 * 33]);
        *(u32x4*)(WT + (size_t)(n0 + n) * ldt + k0 + 8 * c) = o; }
    asm volatile("s_waitcnt lgkmcnt(0)" ::: "memory");
}
__device__ __forceinline__ void ln_row(const float* xrow, const float* g, const float* b, float* orow, bf16_t* obrow, int lane, float* st, bool wx) {
    const f32x4* xr = (const f32x4*)xrow + lane;
    f32x4 v[4]; float s = 0.f;
#pragma unroll
    for (int j = 0; j < 4; ++j) { v[j] = xr[64 * j]; s += (v[j].x + v[j].y) + (v[j].z + v[j].w); }
    const float mean = wave_sum(s) * (1.f / DM); float s2 = 0.f;
#pragma unroll
    for (int j = 0; j < 4; ++j) { v[j] = v[j] - mean; s2 += (v[j].x * v[j].x + v[j].y * v[j].y) + (v[j].z * v[j].z + v[j].w * v[j].w); }
    const float rstd = 1.f / sqrtf(wave_sum(s2) * (1.f / DM) + LN_EPS);
    if (lane == 0) { st[0] = mean; st[1] = rstd; }
#pragma unroll
    for (int j = 0; j < 4; ++j) { const f32x4 gg = ((const f32x4*)g)[lane + 64 * j], bb = ((const f32x4*)b)[lane + 64 * j];
        const f32x4 y = v[j] * rstd * gg + bb;
        if (wx) ((f32x4*)orow)[lane + 64 * j] = y;
        u32x2 w; w.x = cvt_pk_bf16(y.x, y.y); w.y = cvt_pk_bf16(y.z, y.w);
        ((u32x2*)obrow)[lane + 64 * j] = w; }
}
__device__ __forceinline__ void ln_row2(const float* x0, const float* x1, const float* g, const float* b, float* o0, float* o1, bf16_t* ob0, bf16_t* ob1, int lane, float* st0, float* st1, bool wx) {
    const f32x4* xr0 = (const f32x4*)x0 + lane; const f32x4* xr1 = (const f32x4*)x1 + lane;
    f32x4 v[4], w[4]; float s = 0.f, t = 0.f;
#pragma unroll
    for (int j = 0; j < 4; ++j) { v[j] = xr0[64 * j]; w[j] = xr1[64 * j]; }
#pragma unroll
    for (int j = 0; j < 4; ++j) { s += (v[j].x + v[j].y) + (v[j].z + v[j].w); t += (w[j].x + w[j].y) + (w[j].z + w[j].w); }
    const float mean0 = wave_sum(s) * (1.f / DM), mean1 = wave_sum(t) * (1.f / DM); float s2 = 0.f, t2 = 0.f;
#pragma unroll
    for (int j = 0; j < 4; ++j) { v[j] = v[j] - mean0; w[j] = w[j] - mean1; s2 += (v[j].x * v[j].x + v[j].y * v[j].y) + (v[j].z * v[j].z + v[j].w * v[j].w); t2 += (w[j].x * w[j].x + w[j].y * w[j].y) + (w[j].z * w[j].z + w[j].w * w[j].w); }
    const float rstd0 = 1.f / sqrtf(wave_sum(s2) * (1.f / DM) + LN_EPS), rstd1 = 1.f / sqrtf(wave_sum(t2) * (1.f / DM) + LN_EPS);
    if (lane == 0) { st0[0] = mean0; st0[1] = rstd0; st1[0] = mean1; st1[1] = rstd1; }
#pragma unroll
    for (int j = 0; j < 4; ++j) { const f32x4 gg = ((const f32x4*)g)[lane + 64 * j], bb = ((const f32x4*)b)[lane + 64 * j];
        const f32x4 y0 = v[j] * rstd0 * gg + bb, y1 = w[j] * rstd1 * gg + bb;
        if (wx) { ((f32x4*)o0)[lane + 64 * j] = y0; ((f32x4*)o1)[lane + 64 * j] = y1; }
        u32x2 p0; p0.x = cvt_pk_bf16(y0.x, y0.y); p0.y = cvt_pk_bf16(y0.z, y0.w); ((u32x2*)ob0)[lane + 64 * j] = p0;
        u32x2 p1; p1.x = cvt_pk_bf16(y1.x, y1.y); p1.y = cvt_pk_bf16(y1.z, y1.w); ((u32x2*)ob1)[lane + 64 * j] = p1; }
}
__device__ __forceinline__ void sincos_d(double a, double& s, double& c) {
    const double k = rint(a * 0.63661977236758134308);
    double r = fma(-k, 1.57079632679489655800e+00, a); r = fma(-k, 6.12323399573676603587e-17, r);
    const int q = (int)((long long)k & 3);
    const double r2 = r * r;
    const double sp = r * (1.0 + r2 * (-1.0 / 6 + r2 * (1.0 / 120 + r2 * (-1.0 / 5040 + r2 * (1.0 / 362880 + r2 * (-1.0 / 39916800 + r2 * (1.0 / 6227020800.0 + r2 * (-1.0 / 1307674368000.0))))))));
    const double cp = 1.0 + r2 * (-0.5 + r2 * (1.0 / 24 + r2 * (-1.0 / 720 + r2 * (1.0 / 40320 + r2 * (-1.0 / 3628800 + r2 * (1.0 / 479001600.0 + r2 * (-1.0 / 87178291200.0 + r2 * (1.0 / 20922789888000.0))))))));
    s = (q == 0) ? sp : (q == 1) ? cp : (q == 2) ? -sp : -cp;
    c = (q == 0) ? cp : (q == 1) ? -sp : (q == 2) ? -cp : sp;
}


#define LAS __attribute__((address_space(3)))
#define XB_TMO      128
#define XB_XCNT(j)  (256  + 64 * (j))
#define XB_XSUB(j)  (1280 + 64 * (j))
#define XB_XGEN(j)  (2304 + 64 * (j))
#define XB_TOP      3328
#define XB_TOPGEN   3392
#define XCD_BAR_WORDS 3456
#define XB_SPIN_CAP (1u << 18)
__device__ __forceinline__ unsigned xb_ld(unsigned* p)              { return __hip_atomic_load(p, __ATOMIC_RELAXED, __HIP_MEMORY_SCOPE_AGENT); }
__device__ __forceinline__ unsigned xb_add(unsigned* p, unsigned v) { return __hip_atomic_fetch_add(p, v, __ATOMIC_RELAXED, __HIP_MEMORY_SCOPE_AGENT); }
__device__ __forceinline__ unsigned xb_xcc_id() { return (unsigned)__builtin_amdgcn_s_getreg((3 << 11) | 20) & 0xFu; }
#define XB_SPIN(cond, bar) do { unsigned _sp = 0; while (cond) { __builtin_amdgcn_s_sleep(1); \
    if ((++_sp & 255u) == 0u) { if (xb_ld(&(bar)[XB_TMO])) break; if (_sp > XB_SPIN_CAP) { atomicAdd(&(bar)[XB_TMO], 1u); break; } } } } while (0)
struct XcdBarrier { unsigned* bar; unsigned x; volatile LAS unsigned* st; };
__device__ __forceinline__ XcdBarrier xcd_barrier_post(unsigned* bar, volatile LAS unsigned* st) {
    XcdBarrier b; b.bar = bar; b.x = xb_xcc_id(); b.st = st;
    if (threadIdx.x == 0) (void)xb_add(&bar[XB_XCNT(b.x)], 1u);
    return b;
}
__device__ __forceinline__ void xcd_barrier_complete(unsigned* bar, unsigned x, unsigned& nloc, unsigned& nx) {
    const unsigned G = gridDim.x * gridDim.y * gridDim.z;
    unsigned sum, cnt, mine, sp = 0u;
    for (;;) {
        sum = 0u; cnt = 0u; mine = 0u;
#pragma unroll
        for (unsigned j = 0; j < 16; ++j) { const unsigned c = xb_ld(&bar[XB_XCNT(j)]); sum += c; cnt += (c > 0u) ? 1u : 0u; mine = (j == x) ? c : mine; }
        if (sum == G) break;
        __builtin_amdgcn_s_sleep(1);
        if ((++sp & 255u) == 0u) { if (xb_ld(&bar[XB_TMO])) break; if (sp > XB_SPIN_CAP) { atomicAdd(&bar[XB_TMO], 1u); break; } }
    }
    nloc = mine > 0u ? mine : 1u; nx = cnt > 0u ? cnt : 1u;
}
__device__ __forceinline__ void xcd_barrier(const XcdBarrier& b) {
    asm volatile("s_waitcnt vmcnt(0)" ::: "memory");
    __syncthreads();
    if (threadIdx.x == 0) {
        unsigned* bar = b.bar;
        __builtin_amdgcn_s_waitcnt(0);
        unsigned nloc = b.st[0], nx = b.st[1];
        if (nloc == 0u) { xcd_barrier_complete(bar, b.x, nloc, nx); b.st[0] = nloc; b.st[1] = nx; }
        const unsigned old = xb_add(&bar[XB_XSUB(b.x)], 1u);
        const unsigned gen = old / nloc;
        if (old + 1u == (gen + 1u) * nloc) {
            __builtin_amdgcn_fence(__ATOMIC_RELEASE, "agent");
            asm volatile("s_waitcnt vmcnt(0)" ::: "memory");
            const unsigned og = xb_add(&bar[XB_TOP], 1u);
            const unsigned tg = og / nx;
            if (og + 1u == (tg + 1u) * nx) xb_add(&bar[XB_TOPGEN], 1u);
            else XB_SPIN(xb_ld(&bar[XB_TOPGEN]) == tg, bar);
            __builtin_amdgcn_fence(__ATOMIC_ACQUIRE, "agent");
            xb_add(&bar[XB_XGEN(b.x)], 1u);
            asm volatile("s_waitcnt vmcnt(0)" ::: "memory");
        } else {
            XB_SPIN(xb_ld(&bar[XB_XGEN(b.x)]) == gen, bar);
            __builtin_amdgcn_fence(__ATOMIC_ACQUIRE, "agent");
            asm volatile("s_waitcnt vmcnt(0)" ::: "memory");
        }
    }
    __syncthreads();
}

struct Args { const float* in[21]; float* out; unsigned char* ws; int CH; int pad; };
constexpr int LDS_BYTES = 131072 + 1024;

__global__ void __launch_bounds__(NWAVES * 64, 2) mega_fwd(Args args) {
    extern __shared__ __attribute__((aligned(16))) unsigned char lds[];
    cg::grid_group grid = cg::this_grid();
    const int tid = threadIdx.x, lane = tid & 63, wave = __builtin_amdgcn_readfirstlane(tid >> 6);
    const int G = gridDim.x, bx = blockIdx.x;
    const int vcu = (G % 8 == 0) ? (bx % 8) * (G / 8) + bx / 8 : bx;
    unsigned char* ws = args.ws;
    float* lamv = (float*)(ws + WS_CTL);
    float* rope = (float*)(ws + WS_ROPE);
    bf16_t* Win_t = (bf16_t*)(ws + WS_WIN); bf16_t* Wmem_t = (bf16_t*)(ws + WS_WMEM); bf16_t* Wbr_t = (bf16_t*)(ws + WS_WBA);
    bf16_t* Wout_t = (bf16_t*)(ws + WS_WOUT);
    bf16_t* memb = (bf16_t*)(ws + WS_MEMB); bf16_t* kvm = (bf16_t*)(ws + WS_KVM); bf16_t* xb = (bf16_t*)(ws + WS_XB); bf16_t* Hc = (bf16_t*)(ws + WS_H);
    float* rstat = (float*)(ws + WS_H + (size_t)args.CH * INC * 2);
    float* X = args.out;
    const int CH = args.CH, nchunk = NTOK / CH;
    PG8_LAS unsigned char* lds3 = (PG8_LAS unsigned char*)lds;
    volatile LAS unsigned* MISC = (volatile LAS unsigned*)(lds3 + 131072);
    if (tid < 64) MISC[tid] = 0u;
    __syncthreads();
    const XcdBarrier xbar = xcd_barrier_post((unsigned*)(ws + WS_BAR), MISC + 8);
#define GRID_BAR() xcd_barrier(xbar)

    {
        for (int it = bx; it < 256; it += G) {
            const int L = it >> 6, g = (it >> 4) & 3, k0 = (it & 15) * 64;
            float* Wt = (float*)lds; float* Pw = Wt + 64 * 129;
            const float* wsrc = args.in[6] + ((size_t)L * DM + k0) * INC + g * 128;
            for (int e = tid; e < 64 * 128; e += 512) { const int r = e >> 7, c = e & 127; Wt[r * 129 + c] = wsrc[(size_t)r * INC + c]; }
            const float* psrc = args.in[8] + (size_t)(L * 4 + g) * 128 * 128;
            for (int e = tid; e < 128 * 128; e += 512) Pw[e] = psrc[e];
            __syncthreads();
            const int k = tid & 63, dg = tid >> 6;
            float acc[16];
#pragma unroll
            for (int j = 0; j < 16; ++j) acc[j] = 0.f;
            for (int c = 0; c < 128; ++c) { const float a = Wt[k * 129 + c];
#pragma unroll
                for (int j4 = 0; j4 < 4; ++j4) { const f32x4 p = *(const f32x4*)(Pw + c * 128 + dg * 16 + j4 * 4);
                    acc[j4 * 4 + 0] += a * p.x; acc[j4 * 4 + 1] += a * p.y; acc[j4 * 4 + 2] += a * p.z; acc[j4 * 4 + 3] += a * p.w; } }
            bf16_t* dst = Win_t + ((size_t)L * INC + g * 128 + dg * 16) * DM + k0 + k;
#pragma unroll
            for (int j = 0; j < 16; ++j) dst[(size_t)j * DM] = (bf16_t)(cvt_pk_bf16(acc[j], 0.f) & 0xffffu);
            __syncthreads();
        }
        const int gw = bx * NWAVES + wave, NGW = G * NWAVES;
        float* scr = (float*)(lds + wave * 16384);
        constexpr int I_IN = 16 * 272, I_SQ = 16 * 32, I_HF = 8 * 32, I_L = I_IN + 3 * I_SQ + 2 * I_HF;
        for (int it = gw; it < DEPTH * I_L; it += NGW) {
            const int L = it / I_L; int r = it % I_L;
            if (r < I_IN) { transpose_item(args.in[6] + (size_t)L * DM * INC, DM, INC, Win_t + (size_t)L * INC * DM, DM, scr, r / 272, 16 + r % 272, lane); continue; } r -= I_IN;
            if (r < I_SQ) { transpose_item(args.in[7] + (size_t)L * DM * DM, DM, DM, Wmem_t + (size_t)L * DM * DM, DM, scr, r / 32, r % 32, lane); continue; } r -= I_SQ;
            if (r < I_HF) { transpose_item(args.in[15] + (size_t)L * 512 * DM, 512, DM, Wbr_t + (size_t)L * DM * 2048, 2048, scr, r / 32, r % 32, lane); continue; } r -= I_HF;
            if (r < I_SQ) { transpose_item(args.in[16] + (size_t)L * DM * DM, DM, DM, Wbr_t + (size_t)L * DM * 2048 + 512, 2048, scr, r / 32, r % 32, lane); continue; } r -= I_SQ;
            if (r < I_HF) { transpose_item(args.in[17] + (size_t)L * 512 * DM, 512, DM, Wbr_t + (size_t)L * DM * 2048 + 1536, 2048, scr, r / 32, r % 32, lane); continue; } r -= I_HF;
            transpose_item(args.in[18] + (size_t)L * DM * DM, DM, DM, Wout_t + (size_t)L * DM * DM, DM, scr, r / 32, r % 32, lane);
        }
        for (int m = gw; m < MEMROWS; m += NGW) {
            const float* src = (m < 1024) ? args.in[2] + (size_t)m * DM : args.in[3] + (size_t)(m - 1024) * DM;
#pragma unroll
            for (int j = 0; j < 4; ++j) { const f32x4 v = ((const f32x4*)src)[lane + 64 * j]; u32x2 w; w.x = cvt_pk_bf16(v.x, v.y); w.y = cvt_pk_bf16(v.z, v.w); ((u32x2*)(memb + (size_t)m * DM))[lane + 64 * j] = w; }
        }
        for (int m = gw; m < NTOK; m += 2 * NGW) {
            const int m1 = m + NGW;
            const float* src = (m < NP) ? args.in[0] + (size_t)m * DM : args.in[1] + (size_t)(m - NP) * DM;
            if (m1 < NTOK) { const float* src1 = (m1 < NP) ? args.in[0] + (size_t)m1 * DM : args.in[1] + (size_t)(m1 - NP) * DM;
                ln_row2(src, src1, args.in[4], args.in[5], X + (size_t)m * DM, X + (size_t)m1 * DM, xb + (size_t)m * DM, xb + (size_t)m1 * DM, lane, rstat + 2 * (size_t)m, rstat + 2 * (size_t)m1, false); }
            else ln_row(src, args.in[4], args.in[5], X + (size_t)m * DM, xb + (size_t)m * DM, lane, rstat + 2 * (size_t)m, false);
        }
        for (int e = bx * 512 + tid; e < SP * 8; e += G * 512) {
            const int pos = e >> 3, j = e & 7;
            const double inv = (j == 0) ? 1.0 : (j == 1) ? 0.19392274474868576 : (j == 2) ? 0.03760603093086393 : (j == 3) ? 0.007292664737217109 :
                               (j == 4) ? 0.001414213562373095 : (j == 5) ? 0.0002742481756762073 : (j == 6) ? 5.318295896944988e-05 : 1.031338537721246e-05;
            double s, c; sincos_d((double)pos * inv, s, c);
            rope[pos * 16 + j] = (float)c; rope[pos * 16 + 8 + j] = (float)s;
        }
        if (bx == 0 && wave == 0) {
            for (int L = 0; L < DEPTH; ++L) {
                const float d1 = wave_sum(args.in[10][L * 64 + lane] * args.in[11][L * 64 + lane]);
                const float d2 = wave_sum(args.in[12][L * 64 + lane] * args.in[13][L * 64 + lane]);
                const float li = (L == 0) ? 0.20000000000000007f : (L == 1) ? 0.35550906759096934f : (L == 2) ? 0.4707130183435842f : 0.5560582041556406f;
                if (lane == 0) { lamv[L] = expf(d1) - expf(d2) + li; lamv[4 + L] = 1.f - li; }
            }
        }
    }
    grid.sync();
    {
        pg8::Gemm g{memb, Wmem_t, MEMROWS, 4096, DM, DM, DM}; pg8::StaticOrder S; S.init(MEMROWS, 4096, G, bx);
        pg8::EpiStore E{kvm, 4096};
        pg8::gemm_phase<pg8::EpiStore, pg8::StaticOrder, true, true>(lds3, g, S, E);
    }
    const int gw = bx * NWAVES + wave, NGW = G * NWAVES;
    for (int L = 0; L < DEPTH; ++L) {
        for (int c = 0; c < nchunk; ++c) {
            const int row0g = c * CH; const bool prompt = row0g < NP; const int S_ = prompt ? SP : SS;
            {
                pg8::Gemm g{xb + (size_t)row0g * DM, Win_t + (size_t)L * INC * DM, CH, INC, DM, DM, DM}; pg8::StaticOrder S; S.init(CH, INC, G, bx);
                pg8::EpiIn E{Hc, rope, row0g, S_ - 1};
                pg8::gemm_phase<pg8::EpiIn, pg8::StaticOrder, true, true>(lds3, g, S, E);
#if PROBE_P1X2
                pg8::gemm_phase<pg8::EpiIn, pg8::StaticOrder, true, true>(lds3, g, S, E);
#endif
            }
            GRID_BAR();
            {
                const float lam = lamv[L], oscale = lamv[4 + L];
                const int nqb = S_ / 128, nUA = (CH / 128) * 8;
                att::Pre pre = att::pre_zero(); bool have = false;
                for (int u = vcu; u < nUA; u += G) {
                    const int bh = u / nqb, qb = u % nqb, bl = bh >> 3, hd = bh & 7;
                    bf16_t* base = Hc + (size_t)(bl * S_) * INC + hd * 128;
                    const int un = u + G; const bool hn = un < nUA; const int u2 = hn ? un : u;
                    const int bh2 = u2 / nqb, qb2 = u2 % nqb;
                    const int kvo = ((bh2 >> 3) * S_) * INC + (bh2 & 7) * 128;
                    pre = att::attn_unit<0>(base + (size_t)(qb * 128) * INC + C_Q, base + C_K, base + C_V, base + (size_t)(qb * 128) * INC + C_AZ,
                                      S_, (char*)lds, args.in[14] + L * 128, lam, oscale,
                                      pre, have, Hc, hn ? kvo + (qb2 * 128) * INC + C_Q : -1, kvo);
                    have = hn;
                }
                const int nUC = (CH / 256) * 4;
                unsigned* qctr = (unsigned*)(ws + WS_BAR + 14336) + (L * nchunk + c) * 2;
                for (;;) { if (tid == 0) MISC[16] = __hip_atomic_fetch_add(qctr, 1u, __ATOMIC_RELAXED, __HIP_MEMORY_SCOPE_AGENT); __syncthreads(); const int u = (int)MISC[16]; __syncthreads(); if (u >= nUC) break;
                    const int rb = u >> 2, hd = u & 3; const int grow = row0g + rb * 256;
                    const int mb = (grow < NP) ? (grow / SP) : (4 + (grow - NP) / SS);
                    bf16_t* qp = Hc + (size_t)(rb * 256) * INC + hd * 128;
                    const bf16_t* kp = kvm + (size_t)(mb * 256) * 4096 + L * 1024 + hd * 128;
                    { att::Pre dummy = att::pre_zero(); (void)att::attn_unit<1>(qp + C_XQ, kp, kp + 512, qp + C_XZ, 256, (char*)lds, nullptr, 0.f, 0.f, dummy, false, nullptr, -1, 0); }
                }
                const int nUP = CH / 64;
                for (;;) { if (tid == 0) MISC[17] = __hip_atomic_fetch_add(qctr + 1, 1u, __ATOMIC_RELAXED, __HIP_MEMORY_SCOPE_AGENT); __syncthreads(); const int u = (int)MISC[17]; __syncthreads(); if (u >= nUP) break;
                    const int tidp = opaque_tid();
                    const int t0 = u * 64, s0 = (row0g + t0) & (S_ - 1);
                    const bf16_t* sq = Hc + (size_t)(t0 - s0) * INC;
                    unsigned* ubuf = (unsigned*)lds;
                    const int cp = tidp & 255, th = tidp >> 8, ch = cp * 2, half = 1 << (cp >> 6);
                    unsigned wz[32];
#pragma unroll
                    for (int i = 0; i < 32; ++i) wz[i] = *(const unsigned*)(sq + (size_t)(s0 + th * 32 + i) * INC + C_PZ + ch);
#pragma unroll 8
                    for (int it = 0; it < 40; ++it) { const int e = tidp + it * 512; const int r = e >> 8, cq = e & 255, sr_ = s0 - 8 + r;
                        if (e < 79 * 256 && sr_ >= 0 && sr_ < S_) ubuf[e] = *(const unsigned*)(sq + (size_t)sr_ * INC + 2 * cq); }
                    const float ps0 = args.in[9][L * 512 + ch], ps1 = args.in[9][L * 512 + ch + 1];
                    __syncthreads();
                    {
                        const int sf = s0 + th * 32;
                        int lo = sf - half; if (lo < 0) lo = 0;
                        int hi_ = sf + half - 1; if (hi_ > S_ - 1) hi_ = S_ - 1;
                        float a0 = 0.f, a1 = 0.f;
                        for (int r = lo; r <= hi_; ++r) { const unsigned w = ubuf[(r - s0 + 8) * 256 + cp]; a0 += bf_lo(w); a1 += bf_hi(w); }
#pragma unroll
                        for (int i = 0; i < 32; ++i) {
                            const int ti = th * 32 + i, s = sf + i;
                            const unsigned wu = ubuf[(ti + 8) * 256 + cp];
                            const float rc = __builtin_amdgcn_rcpf((float)(hi_ - lo + 1));
                            const float d0 = a0 * rc - bf_lo(wu), d1 = a1 * rc - bf_hi(wu);
                            const float z0 = bf_lo(wz[i]), z1 = bf_hi(wz[i]);
                            const float y0 = d0 * ps0 * z0 * sigmoidf_(z0), y1 = d1 * ps1 * z1 * sigmoidf_(z1);
                            *(unsigned*)(Hc + (size_t)(t0 + ti) * INC + C_PZ + ch) = cvt_pk_bf16(y0, y1);
                            const int nlo = (s + 1 - half) < 0 ? 0 : (s + 1 - half);
                            const int nhi = (s + half) > (S_ - 1) ? (S_ - 1) : (s + half);
                            if (nhi > hi_) { const unsigned w = ubuf[(nhi - s0 + 8) * 256 + cp]; a0 += bf_lo(w); a1 += bf_hi(w); }
                            if (nlo > lo) { const unsigned w = ubuf[(lo - s0 + 8) * 256 + cp]; a0 -= bf_lo(w); a1 -= bf_hi(w); }
                            lo = nlo; hi_ = nhi;
                        }
                    }
                    __syncthreads();
                }
            }
            GRID_BAR();
            {
                pg8::Order3 S; S.base.init(CH, DM, G, bx);
                pg8::Gemm g{Hc, Wbr_t + (size_t)L * DM * 2048, CH, DM, DM, INC, 2048};
                pg8::EpiBr3 E{Hc};
                pg8::gemm_phase<pg8::EpiBr3, pg8::Order3, true, true>(lds3, g, S, E);
            }
            GRID_BAR();
            {
                pg8::Gemm g{Hc + C_AZ, Wout_t + (size_t)L * DM * DM, CH, DM, DM, INC, DM}; pg8::StaticOrder S; S.init(CH, DM, G, bx);
                const float* yin = (L > 0) ? X + (size_t)row0g * DM : (row0g < NP ? args.in[0] + (size_t)row0g * DM : args.in[1] + (size_t)(row0g - NP) * DM);
                pg8::EpiOut E{yin, X + (size_t)row0g * DM, rstat + 2 * (size_t)row0g, (L > 0) ? args.in[19] + (L - 1) * DM : args.in[4], (L > 0) ? args.in[20] + (L - 1) * DM : args.in[5]};
                pg8::gemm_phase<pg8::EpiOut, pg8::StaticOrder, true, true>(lds3, g, S, E);
            }
            GRID_BAR();
            { const int lane5 = opaque_tid() & 63;
              for (int m = row0g + gw; m < row0g + CH; m += 2 * NGW) {
                const int m1 = m + NGW;
                if (m1 < row0g + CH) ln_row2(X + (size_t)m * DM, X + (size_t)m1 * DM, args.in[19] + L * DM, args.in[20] + L * DM, X + (size_t)m * DM, X + (size_t)m1 * DM, xb + (size_t)m * DM, xb + (size_t)m1 * DM, lane5, rstat + 2 * (size_t)m, rstat + 2 * (size_t)m1, L == DEPTH - 1);
                else ln_row(X + (size_t)m * DM, args.in[19] + L * DM, args.in[20] + L * DM, X + (size_t)m * DM, xb + (size_t)m * DM, lane5, rstat + 2 * (size_t)m, L == DEPTH - 1); } }
#if PROBE_SYNC
            for (int q = 0; q < 20; ++q) grid.sync();
#endif
        }
    }
}

extern "C" void kernel_launch(void* const* d_in, const int* in_sizes, int n_in, void* d_out, int out_size, void* d_ws, size_t ws_size, hipStream_t stream) {
    static int grid = 0;
    if (grid == 0) {
        int dev = 0, cus = 0, per_cu = 0;
        if (hipGetDevice(&dev) != hipSuccess || hipDeviceGetAttribute(&cus, hipDeviceAttributeMultiprocessorCount, dev) != hipSuccess) { fprintf(stderr, "kernel_launch: device query failed\n"); grid = -1; return; }
        if (hipFuncSetAttribute((const void*)mega_fwd, hipFuncAttributeMaxDynamicSharedMemorySize, LDS_BYTES) != hipSuccess) { fprintf(stderr, "kernel_launch: hipFuncSetAttribute failed\n"); grid = -1; return; }
        if (hipOccupancyMaxActiveBlocksPerMultiprocessor(&per_cu, (const void*)mega_fwd, NWAVES * 64, LDS_BYTES) != hipSuccess || per_cu < 1) { fprintf(stderr, "kernel_launch: occupancy query failed (%d)\n", per_cu); (void)hipGetLastError(); per_cu = 1; }
        grid = cus * per_cu;
    }
    if (grid < 0) return;
    Args a{};
    for (int i = 0; i < 21; ++i) a.in[i] = (const float*)d_in[i];
    a.out = (float*)d_out; a.ws = (unsigned char*)d_ws;
    int CH = 32768;
    while (CH > 8192 && WS_H + (size_t)CH * INC * 2 + (size_t)NTOK * 8 > ws_size) CH >>= 1;
    if (WS_H + (size_t)CH * INC * 2 + (size_t)NTOK * 8 > ws_size) { fprintf(stderr, "kernel_launch: workspace too small (%zu)\n", ws_size); return; }
    a.CH = CH; a.pad = 0;
    if (hipMemsetAsync((char*)d_ws + WS_BAR, 0, BAR_BYTES, stream) != hipSuccess) { fprintf(stderr, "kernel_launch: memset failed\n"); return; }
    void* kargs[] = {&a};
    hipError_t e = hipLaunchCooperativeKernel((const void*)mega_fwd, dim3(grid), dim3(NWAVES * 64), kargs, LDS_BYTES, stream);
    if (e != hipSuccess) fprintf(stderr, "kernel_launch: cooperative launch failed: %s (grid %d)\n", hipGetErrorString(e), grid);
}
```

```cpp
#include <hip/hip_runtime.h>
#include <hip/hip_cooperative_groups.h>
#include <cstdio>
#include <cstdint>
namespace cg = cooperative_groups;
#define PROBE_ATT2 0
#define PROBE_P1X2 0
#define PROBE_SYNC 0

constexpr int DM = 1024, DEPTH = 4, INC = 9216;
constexpr int NP = 32768, NTOK = 98304;
constexpr int SP = 8192, SS = 4096;
constexpr int C_PZ = 512, C_Q = 1024, C_K = 2048, C_V = 3072, C_AZ = 4096, C_XQ = 5120, C_XZ = 5632, C_GL = 6144;
constexpr int MEMROWS = 20 * 256;
constexpr float ALPHA = 1.681792830507429f;
constexpr float LN_EPS = 1e-5f, SUBLN_EPS = 1e-5f;
constexpr int NWAVES = 8;

typedef unsigned short bf16_t;
typedef short bf16x8 __attribute__((ext_vector_type(8)));
typedef short s16x4 __attribute__((ext_vector_type(4)));
typedef float f32x4 __attribute__((ext_vector_type(4)));
typedef float f32x8 __attribute__((ext_vector_type(8)));
typedef float f32x16 __attribute__((ext_vector_type(16)));
typedef unsigned u32x4 __attribute__((ext_vector_type(4)));
typedef unsigned u32x2 __attribute__((ext_vector_type(2)));

constexpr size_t MiB = 1u << 20;
constexpr size_t WS_CTL = 0;
constexpr size_t WS_ROPE = 4096;
constexpr size_t WS_BAR = 768 * 1024, BAR_BYTES = 16384;
constexpr size_t WS_WIN = 1 * MiB;
constexpr size_t WS_WMEM = 73 * MiB;
constexpr size_t WS_WBA = 81 * MiB;
constexpr size_t WS_WBB = 85 * MiB;
constexpr size_t WS_WBC = 93 * MiB;
constexpr size_t WS_WOUT = 97 * MiB;
constexpr size_t WS_MEMB = 105 * MiB;
constexpr size_t WS_KVM = 115 * MiB;
constexpr size_t WS_XB = 155 * MiB;
constexpr size_t WS_H = 347 * MiB;

__device__ __forceinline__ unsigned cvt_pk_bf16(float lo, float hi) { unsigned r; asm volatile("v_cvt_pk_bf16_f32 %0, %1, %2" : "=v"(r) : "v"(lo), "v"(hi)); return r; }
__device__ __forceinline__ float bf_lo(unsigned u) { return __uint_as_float(u << 16); }
__device__ __forceinline__ float bf_hi(unsigned u) { return __uint_as_float(u & 0xffff0000u); }
__device__ __forceinline__ float bf2f(bf16_t v) { return __uint_as_float(((unsigned)v) << 16); }
__device__ __forceinline__ int opaque_tid() { int t = threadIdx.x; asm volatile("" : "+v"(t)); return t; }
__device__ __forceinline__ float sigmoidf_(float x) { return __builtin_amdgcn_rcpf(1.f + __expf(-x)); }

namespace pg8 {
#define PG8_LAS __attribute__((address_space(3)))
constexpr int BM = 256, BK = 64, HALF = 128, HTB = HALF * BK * 2, STAGE_BYTES = 8 * HTB, NXCD = 8, WGM = 8;

__host__ __device__ __forceinline__ int lds_byte(int r, int c) { const int st = (r >> 4) * 2 + (c >> 5), rr = r & 15, cc = c & 31, ob = rr * 64 + cc * 2; return st * 1024 + (ob ^ (((ob >> 9) & 1) << 5)); }
__host__ __device__ __forceinline__ void stage_rc(int b, int& R, int& C) { const int st = b / 1024, sb = b % 1024, swz = sb ^ (((sb >> 9) & 1) << 5); R = (st >> 1) * 16 + swz / 64; C = (st & 1) * 32 + (swz % 64) / 2; }
__host__ __device__ __forceinline__ int perm32(int rho) { const int n = rho >> 4, i = rho & 15; return 8 * (i >> 2) + 4 * n + (i & 3); }

struct Unit { int pm, pn, br; };
struct Gemm { const bf16_t* A; const bf16_t* Bt; int M, N, K, lda, ldb; };

struct StaticOrder {
    int nM, nN, nwg, G, c;
    __host__ __device__ void init(int M, int N, int G_, int c_) { nM = M / BM; nN = N / BM; nwg = nM * nN; G = G_; c = c_; }
    __host__ __device__ bool next(int i, Unit& u) const {
        const long L = (long)i * G + c; if (L >= nwg) return false;
        int wgid = (int)L; { const int q = nwg / NXCD, r = nwg % NXCD, xcd = wgid % NXCD, off = wgid / NXCD; wgid = (xcd < r ? xcd * (q + 1) : r * (q + 1) + (xcd - r) * q) + off; }
        const int nig = WGM * nN, gid = wgid / nig, fm = gid * WGM, gsz = (nM - fm) < WGM ? (nM - fm) : WGM;
        u.pm = fm + ((wgid % nig) % gsz); u.pn = (wgid % nig) / gsz; u.br = 0; return true;
    }
};
struct Order3 { StaticOrder base;
    __host__ __device__ bool next(int i, Unit& u) const { if (!base.next(i / 3, u)) return false; u.br = i % 3; return true; } };
#define PG8_EPI_DEFAULTS static constexpr bool SELFZERO = false; \
    __device__ static __forceinline__ size_t aoff(const Unit&) { return 0; } \
    __device__ static __forceinline__ size_t boff(const Unit&) { return 0; } \
    __device__ static __forceinline__ int nt(const Unit&, int ntdef) { return ntdef; }


struct EpiStore {
    static constexpr bool PERM = true; PG8_EPI_DEFAULTS
    bf16_t* O; int ldc;
    __device__ __forceinline__ void operator()(const f32x4 (&acc)[2][2][4][2], const Unit& u, int wr, int wc, int fr, int fq) const {
        const int row0 = u.pm * BM + wr * 64 + fr, col0 = u.pn * BM + wc * 32 + 8 * fq;
#pragma unroll
        for (int ai = 0; ai < 2; ++ai)
#pragma unroll
            for (int m = 0; m < 4; ++m) { bf16_t* rowp = O + (size_t)(row0 + ai * HALF + m * 16) * ldc + col0;
#pragma unroll
                for (int bj = 0; bj < 2; ++bj) { const f32x4 v0 = acc[ai][bj][m][0], v1 = acc[ai][bj][m][1];
                    u32x4 w; w.x = cvt_pk_bf16(v0[0], v0[1]); w.y = cvt_pk_bf16(v0[2], v0[3]); w.z = cvt_pk_bf16(v1[0], v1[1]); w.w = cvt_pk_bf16(v1[2], v1[3]);
                    *(u32x4*)(rowp + bj * HALF) = w; } }
    }
};
struct EpiIn {
    static constexpr bool PERM = true; PG8_EPI_DEFAULTS
    bf16_t* H; const float* rope; int row0g, smask;
    __device__ __forceinline__ void operator()(const f32x4 (&acc)[2][2][4][2], const Unit& u, int wr, int wc, int fr, int fq) const {
        const int row0 = u.pm * BM + wr * 64 + fr, colt = u.pn * BM, col0 = colt + wc * 32 + 8 * fq;
        const bool ropewave = (colt >= C_Q && colt < C_V) && ((wc & 1) == 0);
        const float qs = (colt >= C_Q && colt < C_K) ? 0.125f * 1.4426950408889634f : (colt >= C_XQ && colt < C_XZ) ? 0.088388347648318440f * 1.4426950408889634f : 1.f;
#pragma unroll
        for (int ai = 0; ai < 2; ++ai)
#pragma unroll
            for (int m = 0; m < 4; ++m) { const int row = row0 + ai * HALF + m * 16; bf16_t* rowp = H + (size_t)row * INC + col0;
                f32x4 c0 = {1.f, 1.f, 1.f, 1.f}, c1 = c0, s0 = {0.f, 0.f, 0.f, 0.f}, s1 = s0;
                if (ropewave && fq < 2) { const float* rp = rope + (size_t)((row0g + row) & smask) * 16;
                    c0 = *(const f32x4*)rp; c1 = *(const f32x4*)(rp + 4); s0 = *(const f32x4*)(rp + 8); s1 = *(const f32x4*)(rp + 12);
                    if (fq == 0) { s0 = -s0; s1 = -s1; } }
#pragma unroll
                for (int bj = 0; bj < 2; ++bj) { f32x4 v0 = acc[ai][bj][m][0], v1 = acc[ai][bj][m][1];
                    if (ropewave) { f32x4 p0, p1;
#pragma unroll
                        for (int e = 0; e < 4; ++e) { p0[e] = __shfl_xor(v0[e], 16); p1[e] = __shfl_xor(v1[e], 16); }
                        v0 = v0 * c0 + p0 * s0; v1 = v1 * c1 + p1 * s1; }
                    v0 = v0 * qs; v1 = v1 * qs;
                    if (colt >= C_GL) {
#pragma unroll
                        for (int e = 0; e < 4; ++e) { v0[e] = sigmoidf_(fmaxf(v0[e], -30.f)); v1[e] = sigmoidf_(fmaxf(v1[e], -30.f)); } }
                    u32x4 w; w.x = cvt_pk_bf16(v0[0], v0[1]); w.y = cvt_pk_bf16(v0[2], v0[3]); w.z = cvt_pk_bf16(v1[0], v1[1]); w.w = cvt_pk_bf16(v1[2], v1[3]);
                    *(u32x4*)(rowp + bj * HALF) = w; } }
    }
};
__device__ __forceinline__ float gclamp(float x) { return fminf(fmaxf(x, -30.f), 30.f); }
struct EpiBr3 {
    static constexpr bool PERM = true, SELFZERO = true;
    bf16_t* H;
    __device__ static __forceinline__ size_t aoff(const Unit& u) { return (size_t)(u.br == 0 ? C_PZ : u.br == 1 ? C_Q : C_XQ) * 2; }
    __device__ static __forceinline__ size_t boff(const Unit& u) { return (size_t)(u.br == 0 ? 0 : u.br == 1 ? 512 : 1536) * 2; }
    __device__ static __forceinline__ int nt(const Unit& u, int) { return u.br == 1 ? 16 : 8; }
    __device__ __forceinline__ void operator()(f32x4 (&acc)[2][2][4][2], const Unit& u, int wr, int wc, int fr, int fq) const {
        const int row0 = u.pm * BM + wr * 64 + fr, col0 = u.pn * BM + wc * 32 + 8 * fq;
        const int br = u.br;
#pragma unroll
        for (int ai = 0; ai < 2; ++ai)
#pragma unroll
            for (int m = 0; m < 4; ++m) { bf16_t* hrow = H + (size_t)(row0 + ai * HALF + m * 16) * INC;
#pragma unroll
                for (int bj = 0; bj < 2; ++bj) { const int col = col0 + bj * HALF;
                    if (br < 2) {
                        const u32x4 ga = *(const u32x4*)(hrow + C_GL + br * 1024 + col), gb = *(const u32x4*)(hrow + C_GL + (br + 1) * 1024 + col);
                        float r[8];
#pragma unroll
                        for (int e = 0; e < 4; ++e) { const unsigned wa = ga[e], wb = gb[e];
                            r[2 * e]     = bf_lo(wa) * __builtin_amdgcn_rcpf(bf_lo(wb));
                            r[2 * e + 1] = bf_hi(wa) * __builtin_amdgcn_rcpf(bf_hi(wb)); }
                        acc[ai][bj][m][0] *= (f32x4){r[0], r[1], r[2], r[3]}; acc[ai][bj][m][1] *= (f32x4){r[4], r[5], r[6], r[7]};
                    } else {
                        const u32x4 gc = *(const u32x4*)(hrow + C_GL + 2048 + col);
                        f32x4 g0, g1;
                        g0[0] = bf_lo(gc.x); g0[1] = bf_hi(gc.x); g0[2] = bf_lo(gc.y); g0[3] = bf_hi(gc.y);
                        g1[0] = bf_lo(gc.z); g1[1] = bf_hi(gc.z); g1[2] = bf_lo(gc.w); g1[3] = bf_hi(gc.w);
                        const f32x4 v0 = acc[ai][bj][m][0] * g0, v1 = acc[ai][bj][m][1] * g1;
                        u32x4 w; w.x = cvt_pk_bf16(v0[0], v0[1]); w.y = cvt_pk_bf16(v0[2], v0[3]); w.z = cvt_pk_bf16(v1[0], v1[1]); w.w = cvt_pk_bf16(v1[2], v1[3]);
                        *(u32x4*)(hrow + C_AZ + col) = w;
                        acc[ai][bj][m][0] = (f32x4){0.f, 0.f, 0.f, 0.f}; acc[ai][bj][m][1] = (f32x4){0.f, 0.f, 0.f, 0.f};
                    }
                    asm volatile("" ::: "memory"); } }
    }
};
struct EpiOut {
    static constexpr bool PERM = false; PG8_EPI_DEFAULTS
    const float* Yin; float* Yout; const float* stat; const float* g; const float* b;
    __device__ __forceinline__ void operator()(const f32x4 (&acc)[2][2][4][2], const Unit& u, int wr, int wc, int fr, int fq) const {
        const int row0 = u.pm * BM + wr * 64 + fr, col0 = u.pn * BM + wc * 32 + 4 * fq;
#pragma unroll
        for (int ai = 0; ai < 2; ++ai)
#pragma unroll
            for (int m = 0; m < 4; ++m) { const int r = row0 + ai * HALF + m * 16; const size_t off = (size_t)r * DM + col0;
                const float mu = stat[2 * r], rs = stat[2 * r + 1];
#pragma unroll
                for (int bj = 0; bj < 2; ++bj)
#pragma unroll
                    for (int n = 0; n < 2; ++n) { const int c = bj * HALF + n * 16; const f32x4 y = *(const f32x4*)(Yin + off + c);
                        const f32x4 gg = *(const f32x4*)(g + col0 + c), bb = *(const f32x4*)(b + col0 + c);
                        const f32x4 x = (y - mu) * rs * gg + bb;
                        *(f32x4*)(Yout + off + c) = x * ALPHA + acc[ai][bj][m][n]; }
                asm volatile("" ::: "memory"); }
    }
};

template <class Epi, class Sched, bool ALIGN_EPI = false, bool SP2 = false>
__device__ __forceinline__ void gemm_phase(PG8_LAS unsigned char* lds, const Gemm g, const Sched& S, const Epi& E) {
    const int tid = opaque_tid(), wid = __builtin_amdgcn_readfirstlane(tid >> 6), lane = tid & 63, wr = wid >> 2, wc = wid & 3, fr = lane & 15, fq = lane >> 4;
    const int K = g.K; int nt = K / BK;
    unsigned voffA[2], voffB[2];
#pragma unroll
    for (int i = 0; i < 2; ++i) { int R, C; stage_rc(tid * 16 + i * 8192, R, C); const int Rb = Epi::PERM ? ((R & ~31) + perm32(R & 31)) : R;
        voffA[i] = (unsigned)(R * g.lda + C) * 2u; voffB[i] = (unsigned)(Rb * g.ldb + C) * 2u; }
    const size_t kstep = (size_t)(BK * 2);
    const size_t hstepA = (size_t)HALF * g.lda * 2, hstepB = (size_t)HALF * g.ldb * 2;
    const size_t tstepA = 2 * hstepA, tstepB = 2 * hstepB;
    const unsigned ldsw = (unsigned)wid * 1024u;
    const int aoff = lds_byte(wr * 64 + fr, fq * 8), boff = lds_byte(wc * 32 + fr, fq * 8);
#define PG8_SA(b, h) (((b) * 2 + (h)) * HTB)
#define PG8_SB(b, h) ((4 + (b) * 2 + (h)) * HTB)
#define PG8_STAGE(bufoff, gbase, voff) do { _Pragma("unroll") for (int _i = 0; _i < 2; ++_i) \
        __builtin_amdgcn_global_load_lds((const unsigned*)((const char*)(gbase) + (voff)[_i]), (PG8_LAS unsigned*)(lds + (bufoff) + ldsw + _i * 8192), 16, 0, 0); } while (0)
#define PG8_LDA(dst, b, h) do { _Pragma("unroll") for (int m = 0; m < 4; ++m) _Pragma("unroll") for (int k = 0; k < 2; ++k) dst[m][k] = *(const PG8_LAS bf16x8*)(lds + PG8_SA(b, h) + aoff + m * 2048 + k * 1024); } while (0)
#define PG8_LDB(dst, b, h) do { _Pragma("unroll") for (int n = 0; n < 2; ++n) _Pragma("unroll") for (int k = 0; k < 2; ++k) dst[n][k] = *(const PG8_LAS bf16x8*)(lds + PG8_SB(b, h) + boff + n * 2048 + k * 1024); } while (0)
#define PG8_MMA(ai, bj, At, Bt) do { __builtin_amdgcn_s_setprio(1); _Pragma("unroll") for (int m = 0; m < 4; ++m) _Pragma("unroll") for (int n = 0; n < 2; ++n) _Pragma("unroll") for (int k = 0; k < 2; ++k) \
        acc[ai][bj][m][n] = __builtin_amdgcn_mfma_f32_16x16x32_bf16(Bt[n][k], At[m][k], acc[ai][bj][m][n], 0, 0, 0); __builtin_amdgcn_s_setprio(0); } while (0)
#define PG8_WAIT_V(n) asm volatile("s_waitcnt vmcnt(" #n ")" ::: "memory")
#define PG8_WAIT_L(n) asm volatile("s_waitcnt lgkmcnt(" #n ")" ::: "memory")
#define PG8_BAR __builtin_amdgcn_s_barrier()
#define PG8_SCHED __builtin_amdgcn_sched_barrier(0)
    Unit cur, nxt; int ui = 0;
    if (!S.next(0, cur)) return;
    f32x4 acc[2][2][4][2];
#pragma unroll
    for (int a = 0; a < 2; ++a)
#pragma unroll
        for (int b = 0; b < 2; ++b)
#pragma unroll
            for (int m = 0; m < 4; ++m)
#pragma unroll
                for (int n = 0; n < 2; ++n) acc[a][b][m][n] = (f32x4){0.f, 0.f, 0.f, 0.f};
    bf16x8 At[4][2], B0[2][2], B1[2][2];
    const char* cA = (const char*)g.A + (size_t)cur.pm * tstepA + Epi::aoff(cur); const char* cB = (const char*)g.Bt + (size_t)cur.pn * tstepB + Epi::boff(cur);
    nt = Epi::nt(cur, K / BK);
    if constexpr (SP2) {
        PG8_STAGE(PG8_SB(0, 0), cB, voffB); PG8_STAGE(PG8_SB(0, 1), cB + hstepB, voffB); PG8_STAGE(PG8_SA(0, 0), cA, voffA); PG8_STAGE(PG8_SA(0, 1), cA + hstepA, voffA);
        if (wr == 1) PG8_BAR;
        PG8_WAIT_V(2); PG8_BAR;
        PG8_STAGE(PG8_SB(1, 0), cB + kstep, voffB); PG8_STAGE(PG8_SA(1, 0), cA + kstep, voffA); PG8_STAGE(PG8_SB(1, 1), cB + hstepB + kstep, voffB);
        PG8_WAIT_V(6); PG8_BAR;
    } else {
        PG8_STAGE(PG8_SB(0, 0), cB, voffB); PG8_STAGE(PG8_SA(0, 0), cA, voffA); PG8_STAGE(PG8_SB(0, 1), cB + hstepB, voffB); PG8_STAGE(PG8_SA(0, 1), cA + hstepA, voffA);
        if (wr == 1) PG8_BAR;
        PG8_WAIT_V(4); PG8_BAR;
        PG8_STAGE(PG8_SB(1, 0), cB + kstep, voffB); PG8_STAGE(PG8_SA(1, 0), cA + kstep, voffA); PG8_STAGE(PG8_SB(1, 1), cB + hstepB + kstep, voffB);
        PG8_WAIT_V(6); PG8_BAR;
    }
    for (;;) {
        const bool has_next = S.next(ui + 1, nxt);
        const char* nA = has_next ? (const char*)g.A + (size_t)nxt.pm * tstepA + Epi::aoff(nxt) : cA; const char* nB = has_next ? (const char*)g.Bt + (size_t)nxt.pn * tstepB + Epi::boff(nxt) : cB;
        for (int t = 0; t < nt; t += 2) {
            const bool last = (t == nt - 2);
            const char* a1 = cA + (size_t)(t + 1) * kstep;
            const char* a2 = last ? nA : cA + (size_t)(t + 2) * kstep; const char* b2 = last ? nB : cB + (size_t)(t + 2) * kstep;
            const char* a3 = a2 + kstep; const char* b3 = b2 + kstep;
            if constexpr (SP2) {
            PG8_LDB(B0, 0, 0); PG8_LDB(B1, 0, 1); PG8_SCHED; PG8_LDA(At, 0, 0); PG8_STAGE(PG8_SA(1, 1), a1 + hstepA, voffA);
            PG8_WAIT_V(8); PG8_WAIT_L(0); PG8_BAR; PG8_MMA(0, 0, At, B0); PG8_MMA(0, 1, At, B1); PG8_BAR; PG8_SCHED;
            PG8_LDA(At, 0, 1); PG8_STAGE(PG8_SB(0, 0), b2, voffB); PG8_STAGE(PG8_SB(0, 1), b2 + hstepB, voffB); PG8_STAGE(PG8_SA(0, 0), a2, voffA);
            PG8_WAIT_V(8); PG8_WAIT_L(0); PG8_BAR; PG8_MMA(1, 0, At, B0); PG8_MMA(1, 1, At, B1); PG8_BAR; PG8_SCHED;
            PG8_LDB(B0, 1, 0); PG8_LDB(B1, 1, 1); PG8_SCHED; PG8_LDA(At, 1, 0); PG8_STAGE(PG8_SA(0, 1), a2 + hstepA, voffA);
            PG8_WAIT_V(8); PG8_WAIT_L(0); PG8_BAR; PG8_MMA(0, 0, At, B0); PG8_MMA(0, 1, At, B1); PG8_BAR; PG8_SCHED;
            PG8_LDA(At, 1, 1); PG8_STAGE(PG8_SB(1, 0), b3, voffB); PG8_STAGE(PG8_SB(1, 1), b3 + hstepB, voffB); PG8_STAGE(PG8_SA(1, 0), a3, voffA);
            PG8_WAIT_V(8); PG8_WAIT_L(0); PG8_BAR; PG8_MMA(1, 0, At, B0); PG8_MMA(1, 1, At, B1); PG8_BAR; PG8_SCHED;
            } else {
            PG8_LDB(B0, 0, 0); PG8_SCHED; PG8_LDA(At, 0, 0); PG8_STAGE(PG8_SA(1, 1), a1 + hstepA, voffA);
            PG8_WAIT_L(8); PG8_BAR; PG8_WAIT_L(0); PG8_MMA(0, 0, At, B0); PG8_BAR; PG8_SCHED;
            PG8_LDB(B1, 0, 1); PG8_STAGE(PG8_SB(0, 0), b2, voffB);
            PG8_BAR; PG8_WAIT_L(0); PG8_MMA(0, 1, At, B1); PG8_BAR;
            PG8_LDA(At, 0, 1); PG8_STAGE(PG8_SA(0, 0), a2, voffA);
            PG8_BAR; PG8_WAIT_L(0); PG8_MMA(1, 0, At, B0); PG8_BAR; PG8_SCHED;
            PG8_STAGE(PG8_SB(0, 1), b2 + hstepB, voffB);
            PG8_WAIT_V(6); PG8_BAR; PG8_MMA(1, 1, At, B1); PG8_BAR;
            PG8_LDB(B0, 1, 0); PG8_SCHED; PG8_LDA(At, 1, 0); PG8_STAGE(PG8_SA(0, 1), a2 + hstepA, voffA);
            PG8_WAIT_L(8); PG8_BAR; PG8_WAIT_L(0); PG8_MMA(0, 0, At, B0); PG8_BAR; PG8_SCHED;
            PG8_LDB(B1, 1, 1); PG8_STAGE(PG8_SB(1, 0), b3, voffB);
            PG8_BAR; PG8_WAIT_L(0); PG8_MMA(0, 1, At, B1); PG8_BAR;
            PG8_LDA(At, 1, 1); PG8_STAGE(PG8_SA(1, 0), a3, voffA);
            PG8_BAR; PG8_WAIT_L(0); PG8_MMA(1, 0, At, B0); PG8_BAR; PG8_SCHED;
            PG8_STAGE(PG8_SB(1, 1), b3 + hstepB, voffB);
            PG8_WAIT_V(6); PG8_BAR; PG8_MMA(1, 1, At, B1); PG8_BAR;
            }
        }
        if constexpr (ALIGN_EPI) { if (wr == 0) PG8_BAR; }
        E(acc, cur, wr, wc, fr, fq);
        if (!has_next) break;
        if constexpr (!Epi::SELFZERO) {
#pragma unroll
        for (int a = 0; a < 2; ++a)
#pragma unroll
            for (int b = 0; b < 2; ++b)
#pragma unroll
                for (int m = 0; m < 4; ++m)
#pragma unroll
                    for (int n = 0; n < 2; ++n) acc[a][b][m][n] = (f32x4){0.f, 0.f, 0.f, 0.f};
        }
        cur = nxt; cA = nA; cB = nB; ++ui; nt = Epi::nt(cur, K / BK);
        if constexpr (ALIGN_EPI) { if (wr == 1) PG8_BAR; }
    }
    PG8_WAIT_V(0);
    if constexpr (!ALIGN_EPI) { if (wr == 0) PG8_BAR; }
    PG8_BAR;
#undef PG8_SA
#undef PG8_SB
#undef PG8_STAGE
#undef PG8_LDA
#undef PG8_LDB
#undef PG8_MMA
#undef PG8_WAIT_V
#undef PG8_WAIT_L
#undef PG8_BAR
#undef PG8_SCHED
}
}

namespace att {
constexpr int D = 128, QBLK = 32, KVBLK = 64;
constexpr float THR = 8.f;
constexpr int NBUF = 3;
constexpr size_t SHM_V = KVBLK * D * 2, SHM_K = KVBLK * D * 2, SHM_ATTN = NBUF * SHM_V + NBUF * SHM_K + NWAVES * 64 * 4;
#define KSWZ(row, colB) ((row) * 256 + ((colB) ^ (((row) & 7) << 4)))
#define SBAR() __builtin_amdgcn_sched_barrier(0)
__device__ __forceinline__ int crow(int r, int hi) { return (r & 3) + 8 * (r >> 2) + 4 * hi; }
__device__ __forceinline__ bf16x8 ld8(const bf16_t* p) { return *reinterpret_cast<const bf16x8*>(p); }

__device__ __forceinline__ void partialSM(f32x16& p0, f32x16& p1, float& m_reg, float& alpha) {
  constexpr float THR2 = THR * 1.4426950408889634f;
  float pmax = p0[0];
#pragma unroll
  for (int r = 1; r < 16; ++r) pmax = fmaxf(pmax, p0[r]);
#pragma unroll
  for (int r = 0; r < 16; ++r) pmax = fmaxf(pmax, p1[r]);
  { auto rr = __builtin_amdgcn_permlane32_swap(__float_as_uint(pmax), __float_as_uint(pmax), false, false);
    pmax = fmaxf(__uint_as_float(rr[0]), __uint_as_float(rr[1])); }
  float mn;
  if (__builtin_expect(__all(pmax - m_reg <= THR2), 1)) { mn = m_reg; alpha = 1.f; }
  else { mn = fmaxf(m_reg, pmax); alpha = __builtin_amdgcn_exp2f(m_reg - mn); m_reg = mn; }
#pragma unroll
  for (int r = 0; r < 16; ++r) { p0[r] -= mn; p1[r] -= mn; }
#pragma unroll
  for (int r = 0; r < 16; ++r) p0[r] = __builtin_amdgcn_exp2f(p0[r]);
}
__device__ __forceinline__ void finishSM(f32x16& p0, f32x16& p1, float alpha, float& l_reg, bf16x8& pa0, bf16x8& pa1, bf16x8& pa2, bf16x8& pa3) {
#pragma unroll
  for (int r = 0; r < 16; ++r) p1[r] = __builtin_amdgcn_exp2f(p1[r]);
  float ps = 0;
#pragma unroll
  for (int r = 0; r < 16; ++r) ps += p0[r];
#pragma unroll
  for (int r = 0; r < 16; ++r) ps += p1[r];
  { auto rr = __builtin_amdgcn_permlane32_swap(__float_as_uint(ps), __float_as_uint(ps), false, false);
    ps = __uint_as_float(rr[0]) + __uint_as_float(rr[1]); }
  l_reg = l_reg * alpha + ps;
#define PK4(P, BASE, OUT) do { unsigned a0 = cvt_pk_bf16(P[BASE + 0], P[BASE + 1]), a1 = cvt_pk_bf16(P[BASE + 2], P[BASE + 3]);   \
    unsigned b0 = cvt_pk_bf16(P[BASE + 4], P[BASE + 5]), b1 = cvt_pk_bf16(P[BASE + 6], P[BASE + 7]);                              \
    auto r0 = __builtin_amdgcn_permlane32_swap(a0, b0, false, false); auto r1 = __builtin_amdgcn_permlane32_swap(a1, b1, false, false); \
    u32x4 w = {r0[0], r1[0], r0[1], r1[1]}; OUT = *reinterpret_cast<bf16x8*>(&w); } while (0)
  PK4(p0, 0, pa0); PK4(p0, 8, pa1); PK4(p1, 0, pa2); PK4(p1, 8, pa3);
#undef PK4
}
template <int NQ, bool QREG> __device__ __forceinline__ void qkt(f32x16& p0, f32x16& p1, const bf16_t* Ks, const bf16x8* qr, const bf16_t* Qw, int r32, int hi, int qcolB) {
  p0 = f32x16{}; p1 = f32x16{};
#pragma unroll
  for (int d0 = 0; d0 < NQ; ++d0) { int cb = qcolB + (d0 * 16 + hi * 8) * 2;
    bf16x8 b0 = *reinterpret_cast<const bf16x8*>((const char*)Ks + KSWZ(r32, cb));
    bf16x8 b1 = *reinterpret_cast<const bf16x8*>((const char*)Ks + KSWZ(32 + r32, cb));
    const bf16x8 qv = QREG ? qr[d0] : ld8(Qw + d0 * 16);
    p0 = __builtin_amdgcn_mfma_f32_32x32x16_bf16(b0, qv, p0, 0, 0, 0); p1 = __builtin_amdgcn_mfma_f32_32x32x16_bf16(b1, qv, p1, 0, 0, 0); }
  if (QREG) { __builtin_amdgcn_sched_group_barrier(0x100, 2 * NQ, 0); __builtin_amdgcn_sched_group_barrier(0x008, 2 * NQ, 0); }
}
template <int NQ> __device__ __forceinline__ void kload(bf16x8 (&kf)[2 * NQ], const bf16_t* Ks, int r32, int hi, int qcolB) {
#pragma unroll
  for (int d0 = 0; d0 < NQ; ++d0) { int cb = qcolB + (d0 * 16 + hi * 8) * 2;
    kf[2 * d0] = *reinterpret_cast<const bf16x8*>((const char*)Ks + KSWZ(r32, cb)); kf[2 * d0 + 1] = *reinterpret_cast<const bf16x8*>((const char*)Ks + KSWZ(32 + r32, cb)); }
}
template <int NQ> __device__ __forceinline__ void kmfma(f32x16& p0, f32x16& p1, const bf16x8 (&kf)[2 * NQ], const bf16x8* qr) {
  p0 = f32x16{}; p1 = f32x16{};
#pragma unroll
  for (int d0 = 0; d0 < NQ; ++d0) { p0 = __builtin_amdgcn_mfma_f32_32x32x16_bf16(kf[2 * d0], qr[d0], p0, 0, 0, 0); p1 = __builtin_amdgcn_mfma_f32_32x32x16_bf16(kf[2 * d0 + 1], qr[d0], p1, 0, 0, 0); }
}
__device__ __forceinline__ int v_st(int k, int c) { const int kk = (k & ~0xC) | ((k & 4) << 1) | ((k & 8) >> 1); return ((kk >> 3) * 4 + (c >> 5)) * 512 + ((kk & 7) * 32 + (c & 31)) * 2; }
__device__ __forceinline__ int v_rd_base(int lane) { return ((lane & 3) << 3) | (((lane >> 2) & 3) << 6) | (((lane >> 4) & 1) << 5) | (((lane >> 5) & 1) << 8); }
constexpr int v_rd_off(int d0, int ks, int half) { return d0 * 512 + ks * 4096 + half * 2048; }
typedef __attribute__((address_space(3))) const char* lds_cptr;
typedef short v4i16_t __attribute__((ext_vector_type(4)));
__device__ __forceinline__ s16x4 vtr(lds_cptr p) { return __builtin_bit_cast(s16x4, __builtin_amdgcn_ds_read_tr16_b64_v4i16((__attribute__((address_space(3))) v4i16_t*)p)); }
#define VRDK(L, H, KS) do { _Pragma("unroll") for (int d0 = 0; d0 < 4; ++d0) { L[d0] = vtr(vp + v_rd_off(d0, KS, 0)); H[d0] = vtr(vp + v_rd_off(d0, KS, 1)); } } while (0)
#define PK(L, H) (bf16x8){L[0], L[1], L[2], L[3], H[0], H[1], H[2], H[3]}
#define PVK(pa, L, H) do { _Pragma("unroll") for (int d0 = 0; d0 < 4; ++d0) o[d0] = __builtin_amdgcn_mfma_f32_32x32x16_bf16(pa, PK(L[d0], H[d0]), o[d0], 0, 0, 0); } while (0)
template <bool PIPE> __device__ __forceinline__ void pv_d0(f32x16* o, lds_cptr vp, bf16x8 pa0, bf16x8 pa1, bf16x8 pa2, bf16x8 pa3) {
  s16x4 La[4], Ha[4], Lb[4], Hb[4];
  if constexpr (!PIPE) {
    VRDK(La, Ha, 0); PVK(pa0, La, Ha); VRDK(La, Ha, 1); PVK(pa1, La, Ha); VRDK(La, Ha, 2); PVK(pa2, La, Ha); VRDK(La, Ha, 3); PVK(pa3, La, Ha);
    return;
  }
  VRDK(La, Ha, 0); VRDK(Lb, Hb, 1);
  PVK(pa0, La, Ha); VRDK(La, Ha, 2);
  PVK(pa1, Lb, Hb); VRDK(Lb, Hb, 3);
  PVK(pa2, La, Ha); PVK(pa3, Lb, Hb);
  __builtin_amdgcn_sched_group_barrier(0x100, 16, 0); __builtin_amdgcn_sched_group_barrier(0x008, 4, 0);
  __builtin_amdgcn_sched_group_barrier(0x100, 8, 0);  __builtin_amdgcn_sched_group_barrier(0x008, 4, 0);
  __builtin_amdgcn_sched_group_barrier(0x100, 8, 0);  __builtin_amdgcn_sched_group_barrier(0x008, 8, 0);
}
__device__ __forceinline__ void pv_pref(s16x4 (&La)[4], s16x4 (&Ha)[4], s16x4 (&Lb)[4], s16x4 (&Hb)[4], lds_cptr vp) { VRDK(La, Ha, 0); }
__device__ __forceinline__ void pv_rest(f32x16* o, s16x4 (&La)[4], s16x4 (&Ha)[4], s16x4 (&Lb)[4], s16x4 (&Hb)[4], lds_cptr vp, bf16x8 pa0, bf16x8 pa1, bf16x8 pa2, bf16x8 pa3) {
  VRDK(Lb, Hb, 1);
  PVK(pa0, La, Ha); VRDK(La, Ha, 2);
  PVK(pa1, Lb, Hb); VRDK(Lb, Hb, 3);
  PVK(pa2, La, Ha); PVK(pa3, Lb, Hb);
  __builtin_amdgcn_sched_group_barrier(0x100, 8, 0); __builtin_amdgcn_sched_group_barrier(0x008, 4, 0); __builtin_amdgcn_sched_group_barrier(0x100, 8, 0);  __builtin_amdgcn_sched_group_barrier(0x008, 4, 0);
  __builtin_amdgcn_sched_group_barrier(0x100, 8, 0);  __builtin_amdgcn_sched_group_barrier(0x008, 8, 0);
}
#undef VRDK
#undef PK
#undef PVK

__device__ __forceinline__ void store_gated(const f32x16* v, float* stg, bf16_t* out, const bf16_t* gate, int lane, int r32, int hi, bool write) {
#pragma unroll
  for (int d0 = 0; d0 < 4; ++d0)
#pragma unroll
    for (int r = 0; r < 16; ++r) stg[crow(r, hi) * 128 + d0 * 32 + r32] = v[d0][r];
  asm volatile("s_waitcnt lgkmcnt(0)" ::: "memory");
#pragma unroll
  for (int it = 0; it < 8; ++it) {
    const int row = it * 4 + (lane >> 4), c8 = (lane & 15) * 8;
    const f32x4 a = *(const f32x4*)(stg + row * 128 + c8), b = *(const f32x4*)(stg + row * 128 + c8 + 4);
    const u32x4 g = *(const u32x4*)(gate + (long)row * INC + c8);
    float z[8] = {bf_lo(g.x), bf_hi(g.x), bf_lo(g.y), bf_hi(g.y), bf_lo(g.z), bf_hi(g.z), bf_lo(g.w), bf_hi(g.w)};
    float y[8];
#pragma unroll
    for (int e = 0; e < 8; ++e) y[e] = (e < 4 ? a[e] : b[e - 4]) * z[e] * sigmoidf_(z[e]);
    u32x4 w; w.x = cvt_pk_bf16(y[0], y[1]); w.y = cvt_pk_bf16(y[2], y[3]); w.z = cvt_pk_bf16(y[4], y[5]); w.w = cvt_pk_bf16(y[6], y[7]);
    if (write) *(u32x4*)(out + (long)row * INC + c8) = w; else if (y[0] == 123.456f) out[0] = 0;
  }
}

__device__ __forceinline__ void store_gated_half(const float (&w)[4][8], float* stg, bf16_t* out, u32x4 g0_, u32x4 g1_, u32x4 g2_, u32x4 g3_, int lane, int r32, int hi, bool write) {
#pragma unroll
  for (int d0 = 0; d0 < 4; ++d0)
#pragma unroll
    for (int q = 0; q < 8; ++q) stg[crow(q, hi) * 128 + d0 * 32 + r32] = w[d0][q];
  asm volatile("s_waitcnt lgkmcnt(0)" ::: "memory");
#pragma unroll
  for (int it = 0; it < 4; ++it) {
    const int row = it * 4 + (lane >> 4), c8 = (lane & 15) * 8;
    const f32x4 a = *(const f32x4*)(stg + row * 128 + c8), b = *(const f32x4*)(stg + row * 128 + c8 + 4);
    const u32x4 g = (it == 0) ? g0_ : (it == 1) ? g1_ : (it == 2) ? g2_ : g3_;
    float z[8] = {bf_lo(g.x), bf_hi(g.x), bf_lo(g.y), bf_hi(g.y), bf_lo(g.z), bf_hi(g.z), bf_lo(g.w), bf_hi(g.w)};
    float y[8];
#pragma unroll
    for (int e = 0; e < 8; ++e) y[e] = (e < 4 ? a[e] : b[e - 4]) * z[e] * sigmoidf_(z[e]);
    u32x4 wv; wv.x = cvt_pk_bf16(y[0], y[1]); wv.y = cvt_pk_bf16(y[2], y[3]); wv.z = cvt_pk_bf16(y[4], y[5]); wv.w = cvt_pk_bf16(y[6], y[7]);
    if (write) *(u32x4*)(out + (long)row * INC + c8) = wv; else if (y[0] == 123.456f) out[0] = 0;
  }
}

struct Stg { bf16x8 vs0, vs1, ks0, ks1; };
struct Pre { bf16x8 q0, q1, q2, q3, vs0, vs1, ks0, ks1, vb0, vb1, kb0, kb1; };
__device__ __forceinline__ Pre pre_zero() { Pre p; const bf16x8 z_ = {}; p.q0 = z_; p.q1 = z_; p.q2 = z_; p.q3 = z_; p.vs0 = z_; p.vs1 = z_; p.ks0 = z_; p.ks1 = z_; p.vb0 = z_; p.vb1 = z_; p.kb0 = z_; p.kb1 = z_; return p; }
template <int MODE, bool WRITE = true>
__device__ __forceinline__ Pre attn_unit(bf16_t* Qb, const bf16_t* __restrict__ Kh, const bf16_t* __restrict__ Vh, const bf16_t* Gz,
                                          int seq, char* lds, const float* subg, float lam, float oscale,
                                          const Pre pin, bool have_pre, const bf16_t* Hb, int qoff_next, int kvoff_next) {
  Pre pout = pre_zero();
  constexpr int LDQ = INC, LDK = MODE == 0 ? INC : 4096, NQ = MODE == 0 ? 4 : 8;
  const int tid = opaque_tid(), wid = __builtin_amdgcn_readfirstlane(tid >> 6), lane = tid & 63, r32 = lane & 31, hi = lane >> 5;
  const int rg = MODE == 0 ? (wid & 3) : wid, comp = MODE == 0 ? (wid >> 2) : 0;
  bf16_t* V_lds = (bf16_t*)lds; bf16_t* K_lds = (bf16_t*)(lds + NBUF * SHM_V);
  float* ws = (float*)(lds + NBUF * SHM_V + NBUF * SHM_K) + wid * 64; float* li_l = ws; float* al_l = ws + 32;
  float m_run = -1e30f, l_reg = 0.f; f32x16 o[4] = {}; bf16x8 qr[NQ];
  const bf16_t* Qw = Qb + (long)(rg * QBLK + r32) * LDQ + comp * 64 + hi * 8;
  const int qcolB = comp * 128;
#pragma unroll
  for (int d0 = 0; d0 < NQ; ++d0) qr[d0] = bf16x8{};
  if (MODE == 0 && have_pre) { qr[0] = pin.q0; qr[1] = pin.q1; qr[2] = pin.q2; qr[3] = pin.q3; }
  else {
#pragma unroll
    for (int d0 = 0; d0 < NQ; ++d0) qr[d0] = ld8(Qw + d0 * 16); }
  const int sr = tid >> 4, sc = (tid & 15) * 8, vst0 = v_st(sr, sc), vst1 = v_st(32 + sr, sc);
  const lds_cptr vb0 = (lds_cptr)lds + v_rd_base(lane);
  Stg stA, stB;
  const int soff0 = sr * LDK + sc, soff1 = soff0 + 32 * LDK;
#define SLOAD(S, k0) do { const bf16_t* vt_ = Vh + (long)(k0) * LDK; const bf16_t* kt_ = Kh + (long)(k0) * LDK; \
    S.vs0 = ld8(vt_ + soff0); S.vs1 = ld8(vt_ + soff1); S.ks0 = ld8(kt_ + soff0); S.ks1 = ld8(kt_ + soff1); } while (0)
#define SWRITE(S, b) do { *(bf16x8*)((char*)V_lds + (b) * SHM_V + vst0) = S.vs0;          \
    *(bf16x8*)((char*)V_lds + (b) * SHM_V + vst1) = S.vs1; int kc = sc * 2;               \
    *(bf16x8*)((char*)K_lds + (b) * SHM_K + KSWZ(sr, kc)) = S.ks0;                       \
    *(bf16x8*)((char*)K_lds + (b) * SHM_K + KSWZ(32 + sr, kc)) = S.ks1; } while (0)
#define RESC(a) do { if (__any((a) < 1.f)) { if (hi == 0) al_l[r32] = (a); asm volatile("s_waitcnt lgkmcnt(0)" ::: "memory"); \
    _Pragma("unroll") for (int r = 0; r < 16; ++r) { const float a_ = al_l[crow(r, hi)]; _Pragma("unroll") for (int d = 0; d < 4; ++d) o[d][r] *= a_; } } } while (0)
  const int grp = wid >> 2;
  f32x16 p0, p1; float al; bf16x8 pa0, pa1, pa2, pa3; const int NT = seq / KVBLK;
  if (MODE == 0 && have_pre) { stA.vs0 = pin.vs0; stA.vs1 = pin.vs1; stA.ks0 = pin.ks0; stA.ks1 = pin.ks1; } else { SLOAD(stA, 0); }
  asm volatile("s_waitcnt vmcnt(0)" ::: "memory"); SWRITE(stA, 0);
  if constexpr (MODE == 0) { if (have_pre) { stB.vs0 = pin.vb0; stB.vs1 = pin.vb1; stB.ks0 = pin.kb0; stB.ks1 = pin.kb1; } else { SLOAD(stB, KVBLK); } if (2 < NT) SLOAD(stA, 2 * KVBLK); } else { SLOAD(stA, KVBLK); }
  __syncthreads();
#define WGBAR() asm volatile("s_waitcnt lgkmcnt(0)\n\ts_barrier" ::: "memory")
#define ROT() do { const int t_ = bprv; bprv = bcur; bcur = bnxt; bnxt = t_; } while (0)
#define MID(S, j) do { SBAR(); if ((j) + 1 < NT) { SWRITE(S, bnxt); } if ((j) + (MODE == 0 ? 3 : 2) < NT) SLOAD(S, ((j) + (MODE == 0 ? 3 : 2)) * KVBLK); SBAR(); } while (0)
#define IV0(S, j) do { const bf16_t* Kc = (const bf16_t*)((const char*)K_lds + bcur * SHM_K); const lds_cptr vbp = vb0 + bprv * (int)SHM_V; \
      SBAR(); __builtin_amdgcn_s_setprio(1); qkt<NQ, true>(p0, p1, Kc, qr, Qw, r32, hi, qcolB); \
      if ((j) > 0) pv_d0<MODE == 0>(o, vbp, pa0, pa1, pa2, pa3); \
      __builtin_amdgcn_s_setprio(0); MID(S, j); \
      partialSM(p0, p1, m_run, al); RESC(al); finishSM(p0, p1, al, l_reg, pa0, pa1, pa2, pa3); SBAR(); \
      WGBAR(); ROT(); } while (0)
#define IV1(S, j) do { const bf16_t* Kc = (const bf16_t*)((const char*)K_lds + bcur * SHM_K); const lds_cptr vbp = vb0 + bprv * (int)SHM_V; \
      if ((j) > 0) { SBAR(); partialSM(p0, p1, m_run, al); RESC(al); finishSM(p0, p1, al, l_reg, pa0, pa1, pa2, pa3); } \
      MID(S, j); \
      __builtin_amdgcn_s_setprio(1); if ((j) > 0) pv_d0<MODE == 0>(o, vbp, pa0, pa1, pa2, pa3); \
      SBAR(); qkt<NQ, true>(p0, p1, Kc, qr, Qw, r32, hi, qcolB); __builtin_amdgcn_s_setprio(0); SBAR(); \
      WGBAR(); ROT(); } while (0)
  int bprv = 2, bcur = 0, bnxt = 1;
  if constexpr (MODE == 0) {
#define JV0(S, j) do { const bf16_t* Kc = (const bf16_t*)((const char*)K_lds + bcur * SHM_K); const lds_cptr vbp = vb0 + bprv * (int)SHM_V; \
      SBAR(); __builtin_amdgcn_s_setprio(1); \
      if ((j) > 0) pv_d0<true>(o, vbp, pa0, pa1, pa2, pa3); \
      SBAR(); qkt<NQ, true>(p0, p1, Kc, qr, Qw, r32, hi, qcolB); __builtin_amdgcn_s_setprio(0); MID(S, j); \
      partialSM(p0, p1, m_run, al); RESC(al); finishSM(p0, p1, al, l_reg, pa0, pa1, pa2, pa3); SBAR(); \
      WGBAR(); ROT(); } while (0)
#define JV1(S, j) do { const bf16_t* Kc = (const bf16_t*)((const char*)K_lds + bcur * SHM_K); const lds_cptr vbp = vb0 + bprv * (int)SHM_V; \
      if ((j) > 0) { SBAR(); partialSM(p0, p1, m_run, al); RESC(al); finishSM(p0, p1, al, l_reg, pa0, pa1, pa2, pa3); } \
      MID(S, j); \
      __builtin_amdgcn_s_setprio(1); if ((j) > 0) pv_d0<true>(o, vbp, pa0, pa1, pa2, pa3); \
      SBAR(); qkt<NQ, true>(p0, p1, Kc, qr, Qw, r32, hi, qcolB); __builtin_amdgcn_s_setprio(0); SBAR(); \
      WGBAR(); ROT(); } while (0)
    if (grp == 0) {
      for (int j = 0; j < NT; j += 2) { JV0(stB, j); JV0(stA, j + 1); }
      SBAR(); pv_d0<true>(o, vb0 + bprv * (int)SHM_V, pa0, pa1, pa2, pa3);
    } else {
      for (int j = 0; j < NT; j += 2) { JV1(stB, j); JV1(stA, j + 1); }
      SBAR(); partialSM(p0, p1, m_run, al); RESC(al); finishSM(p0, p1, al, l_reg, pa0, pa1, pa2, pa3); SBAR();
      pv_d0<true>(o, vb0 + bprv * (int)SHM_V, pa0, pa1, pa2, pa3);
    }
#undef JV0
#undef JV1
  } else {
  if (grp == 0) {
    for (int j = 0; j < NT; j += 2) { IV0(stA, j); IV0(stA, j + 1); }
  } else {
    for (int j = 0; j < NT; j += 2) { IV1(stA, j); IV1(stA, j + 1); }
    SBAR(); partialSM(p0, p1, m_run, al); RESC(al); finishSM(p0, p1, al, l_reg, pa0, pa1, pa2, pa3); SBAR();
  }
  pv_d0<MODE == 0>(o, vb0 + bprv * (int)SHM_V, pa0, pa1, pa2, pa3);
  }
#undef WGBAR
#undef ROT
#undef MID
#undef IV0
#undef IV1
  if (hi == 0) li_l[r32] = l_reg; asm volatile("s_waitcnt lgkmcnt(0)" ::: "memory");
  float rli[16];
#pragma unroll
  for (int r = 0; r < 16; ++r) rli[r] = __builtin_amdgcn_rcpf(li_l[crow(r, hi)]);
#pragma unroll
  for (int d0 = 0; d0 < 4; ++d0)
#pragma unroll
    for (int r = 0; r < 16; ++r) o[d0][r] *= rli[r];
  if constexpr (MODE == 0) {
    u32x4 gq0, gq1, gq2, gq3;
    { const bf16_t* gw_ = Gz + (long)(rg * QBLK + comp * 16 + (lane >> 4)) * INC + (lane & 15) * 8;
      gq0 = *(const u32x4*)gw_; gq1 = *(const u32x4*)(gw_ + 4 * INC); gq2 = *(const u32x4*)(gw_ + 8 * INC); gq3 = *(const u32x4*)(gw_ + 12 * INC); }
    __syncthreads();
    float* xw = (float*)lds + wid * 2048 + lane; const float* xr = (const float*)lds + (wid ^ 4) * 2048 + lane;
#pragma unroll
    for (int d0 = 0; d0 < 4; ++d0)
#pragma unroll
      for (int q = 0; q < 8; ++q) xw[(d0 * 8 + q) * 64] = (comp == 0) ? o[d0][8 + q] : o[d0][q];
    __syncthreads();
    float w[4][8];
#pragma unroll
    for (int d0 = 0; d0 < 4; ++d0)
#pragma unroll
      for (int q = 0; q < 8; ++q) { const float x = xr[(d0 * 8 + q) * 64]; w[d0][q] = (comp == 0) ? (o[d0][q] - lam * x) : (x - lam * o[d0][8 + q]); }
    if (qoff_next >= 0) {
      const bf16_t* Qwn = Hb + qoff_next + (long)(rg * QBLK + r32) * LDQ + comp * 64 + hi * 8; const bf16_t* Kh_next = Hb + kvoff_next + C_K; const bf16_t* Vh_next = Hb + kvoff_next + C_V;
      pout.q0 = ld8(Qwn); pout.q1 = ld8(Qwn + 16); pout.q2 = ld8(Qwn + 32); pout.q3 = ld8(Qwn + 48);
      pout.vs0 = ld8(Vh_next + soff0); pout.vs1 = ld8(Vh_next + soff1); pout.ks0 = ld8(Kh_next + soff0); pout.ks1 = ld8(Kh_next + soff1);
      pout.vb0 = ld8(Vh_next + KVBLK * LDK + soff0); pout.vb1 = ld8(Vh_next + KVBLK * LDK + soff1); pout.kb0 = ld8(Kh_next + KVBLK * LDK + soff0); pout.kb1 = ld8(Kh_next + KVBLK * LDK + soff1);
    }
    float g4[4];
#pragma unroll
    for (int d0 = 0; d0 < 4; ++d0) g4[d0] = subg[d0 * 32 + r32] * oscale;
#pragma unroll
    for (int q = 0; q < 8; ++q) {
      float ss = w[0][q] * w[0][q] + w[1][q] * w[1][q] + w[2][q] * w[2][q] + w[3][q] * w[3][q];
      ss += __shfl_xor(ss, 1); ss += __shfl_xor(ss, 2); ss += __shfl_xor(ss, 4); ss += __shfl_xor(ss, 8); ss += __shfl_xor(ss, 16);
      const float rs = __builtin_amdgcn_rsqf(ss * (1.f / 128.f) + SUBLN_EPS);
#pragma unroll
      for (int d0 = 0; d0 < 4; ++d0) w[d0][q] *= rs * g4[d0];
    }
    store_gated_half(w, (float*)lds + 16384 + wid * 2048, Qb + (long)(rg * QBLK + comp * 16) * INC, gq0, gq1, gq2, gq3, lane, r32, hi, WRITE);
  } else {
    __syncthreads();
    store_gated(o, (float*)lds + wid * 4096, Qb + (long)(rg * QBLK) * INC, Gz + (long)(rg * QBLK) * INC, lane, r32, hi, WRITE);
  }
  __syncthreads();
  return pout;
#undef SLOAD
#undef SWRITE
#undef RESC
}
#undef KSWZ
#undef SBAR
}

__device__ __forceinline__ float wave_sum(float v) {
#pragma unroll
    for (int o = 1; o < 64; o <<= 1) v += __shfl_xor(v, o);
    return v;
}
__device__ __forceinline__ void transpose_item(const float* W, int K, int N, bf16_t* WT, int ldt, float* scr, int kb, int nb, int lane) {
    const int k0 = 64 * kb, n0 = 32 * nb;
#pragma unroll 8
    for (int i = 0; i < 32; ++i) { const int kk = 2 * i + (lane >> 5); scr[kk * 33 + (lane & 31)] = W[(size_t)(k0 + kk) * N + n0 + (lane & 31)]; }
    asm volatile("s_waitcnt lgkmcnt(0)" ::: "memory");
    const int c = lane & 7;
#pragma unroll
    for (int j = 0; j < 4; ++j) { const int n = (lane >> 3) + 8 * j; const float* s = scr + (8 * c) * 33 + n;
        u32x4 o; o.x = cvt_pk_bf16(s[0 * 33], s[1 * 33]); o.y = cvt_pk_bf16(s[2 * 33], s[3 * 33]); o.z = cvt_pk_bf16(s[4 * 33], s[5 * 33]); o.w = cvt_pk_bf16(s[6 * 33], s[7 * 33]);
        *(u32x4*)(WT + (size_t)(n0 + n) * ldt + k0 + 8 * c) = o; }
    asm volatile("s_waitcnt lgkmcnt(0)" ::: "memory");
}
__device__ __forceinline__ void ln_row(const float* xrow, const float* g, const float* b, float* orow, bf16_t* obrow, int lane, float* st, bool wx) {
    const f32x4* xr = (const f32x4*)xrow + lane;
    f32x4 v[4]; float s = 0.f;
#pragma unroll
    for (int j = 0; j < 4; ++j) { v[j] = xr[64 * j]; s += (v[j].x + v[j].y) + (v[j].z + v[j].w); }
    const float mean = wave_sum(s) * (1.f / DM); float s2 = 0.f;
#pragma unroll
    for (int j = 0; j < 4; ++j) { v[j] = v[j] - mean; s2 += (v[j].x * v[j].x + v[j].y * v[j].y) + (v[j].z * v[j].z + v[j].w * v[j].w); }
    const float rstd = 1.f / sqrtf(wave_sum(s2) * (1.f / DM) + LN_EPS);
    if (lane == 0) { st[0] = mean; st[1] = rstd; }
#pragma unroll
    for (int j = 0; j < 4; ++j) { const f32x4 gg = ((const f32x4*)g)[lane + 64 * j], bb = ((const f32x4*)b)[lane + 64 * j];
        const f32x4 y = v[j] * rstd * gg + bb;
        if (wx) ((f32x4*)orow)[lane + 64 * j] = y;
        u32x2 w; w.x = cvt_pk_bf16(y.x, y.y); w.y = cvt_pk_bf16(y.z, y.w);
        ((u32x2*)obrow)[lane + 64 * j] = w; }
}
__device__ __forceinline__ void ln_row2(const float* x0, const float* x1, const float* g, const float* b, float* o0, float* o1, bf16_t* ob0, bf16_t* ob1, int lane, float* st0, float* st1, bool wx) {
    const f32x4* xr0 = (const f32x4*)x0 + lane; const f32x4* xr1 = (const f32x4*)x1 + lane;
    f32x4 v[4], w[4]; float s = 0.f, t = 0.f;
#pragma unroll
    for (int j = 0; j < 4; ++j) { v[j] = xr0[64 * j]; w[j] = xr1[64 * j]; }
#pragma unroll
    for (int j = 0; j < 4; ++j) { s += (v[j].x + v[j].y) + (v[j].z + v[j].w); t += (w[j].x + w[j].y) + (w[j].z + w[j].w); }
    const float mean0 = wave_sum(s) * (1.f / DM), mean1 = wave_sum(t) * (1.f / DM); float s2 = 0.f, t2 = 0.f;
#pragma unroll
    for (int j = 0; j < 4; ++j) { v[j] = v[j] - mean0; w[j] = w[j] - mean1; s2 += (v[j].x * v[j].x + v[j].y * v[j].y) + (v[j].z * v[j].z + v[j].w * v[j].w); t2 += (w[j].x * w[j].x + w[j].y * w[j].y) + (w[j].z * w[j].z + w[j].w * w[j].w); }
    const float rstd0 = 1.f / sqrtf(wave_sum(s2) * (1.f / DM) + LN_EPS), rstd1 = 1.f / sqrtf(wave_sum(t2) * (1.f / DM) + LN_EPS);
    if (lane == 0) { st0[0] = mean0; st0[1] = rstd0; st1[0] = mean1; st1[1] = rstd1; }
#pragma unroll
    for (int j = 0; j < 4; ++j) { const f32x4 gg = ((const f32x4*)g)[lane + 64 * j], bb = ((const f32x4*)b)[lane + 64 * j];
        const f32x4 y0 = v[j] * rstd0 * gg + bb, y1 = w[j] * rstd1 * gg + bb;
        if (wx) { ((f32x4*)o0)[lane + 64 * j] = y0; ((f32x4*)o1)[lane + 64 * j] = y1; }
        u32x2 p0; p0.x = cvt_pk_bf16(y0.x, y0.y); p0.y = cvt_pk_bf16(y0.z, y0.w); ((u32x2*)ob0)[lane + 64 * j] = p0;
        u32x2 p1; p1.x = cvt_pk_bf16(y1.x, y1.y); p1.y = cvt_pk_bf16(y1.z, y1.w); ((u32x2*)ob1)[lane + 64 * j] = p1; }
}
__device__ __forceinline__ void sincos_d(double a, double& s, double& c) {
    const double k = rint(a * 0.63661977236758134308);
    double r = fma(-k, 1.57079632679489655800e+00, a); r = fma(-k, 6.12323399573676603587e-17, r);
    const int q = (int)((long long)k & 3);
    const double r2 = r * r;
    const double sp = r * (1.0 + r2 * (-1.0 / 6 + r2 * (1.0 / 120 + r2 * (-1.0 / 5040 + r2 * (1.0 / 362880 + r2 * (-1.0 / 39916800 + r2 * (1.0 / 6227020800.0 + r2 * (-1.0 / 1307674368000.0))))))));
    const double cp = 1.0 + r2 * (-0.5 + r2 * (1.0 / 24 + r2 * (-1.0 / 720 + r2 * (1.0 / 40320 + r2 * (-1.0 / 3628800 + r2 * (1.0 / 479001600.0 + r2 * (-1.0 / 87178291200.0 + r2 * (1.0 / 20922789888000.0))))))));
    s = (q == 0) ? sp : (q == 1) ? cp : (q == 2) ? -sp : -cp;
    c = (q == 0) ? cp : (q == 1) ? -sp : (q == 2) ? -cp : sp;
}


#define LAS __attribute__((address_space(3)))
#define XB_TMO      128
#define XB_XCNT(j)  (256  + 64 * (j))
#define XB_XSUB(j)  (1280 + 64 * (j))
#define XB_XGEN(j)  (2304 + 64 * (j))
#define XB_TOP      3328
#define XB_TOPGEN   3392
#define XCD_BAR_WORDS 3456
#define XB_SPIN_CAP (1u << 18)
__device__ __forceinline__ unsigned xb_ld(unsigned* p)              { return __hip_atomic_load(p, __ATOMIC_RELAXED, __HIP_MEMORY_SCOPE_AGENT); }
__device__ __forceinline__ unsigned xb_add(unsigned* p, unsigned v) { return __hip_atomic_fetch_add(p, v, __ATOMIC_RELAXED, __HIP_MEMORY_SCOPE_AGENT); }
__device__ __forceinline__ unsigned xb_xcc_id() { return (unsigned)__builtin_amdgcn_s_getreg((3 << 11) | 20) & 0xFu; }
#define XB_SPIN(cond, bar) do { unsigned _sp = 0; while (cond) { __builtin_amdgcn_s_sleep(1); \
    if ((++_sp & 255u) == 0u) { if (xb_ld(&(bar)[XB_TMO])) break; if (_sp > XB_SPIN_CAP) { atomicAdd(&(bar)[XB_TMO], 1u); break; } } } } while (0)
struct XcdBarrier { unsigned* bar; unsigned x; volatile LAS unsigned* st; };
__device__ __forceinline__ XcdBarrier xcd_barrier_post(unsigned* bar, volatile LAS unsigned* st) {
    XcdBarrier b; b.bar = bar; b.x = xb_xcc_id(); b.st = st;
    if (threadIdx.x == 0) (void)xb_add(&bar[XB_XCNT(b.x)], 1u);
    return b;
}
__device__ __forceinline__ void xcd_barrier_complete(unsigned* bar, unsigned x, unsigned& nloc, unsigned& nx) {
    const unsigned G = gridDim.x * gridDim.y * gridDim.z;
    unsigned sum, cnt, mine, sp = 0u;
    for (;;) {
        sum = 0u; cnt = 0u; mine = 0u;
#pragma unroll
        for (unsigned j = 0; j < 16; ++j) { const unsigned c = xb_ld(&bar[XB_XCNT(j)]); sum += c; cnt += (c > 0u) ? 1u : 0u; mine = (j == x) ? c : mine; }
        if (sum == G) break;
        __builtin_amdgcn_s_sleep(1);
        if ((++sp & 255u) == 0u) { if (xb_ld(&bar[XB_TMO])) break; if (sp > XB_SPIN_CAP) { atomicAdd(&bar[XB_TMO], 1u); break; } }
    }
    nloc = mine > 0u ? mine : 1u; nx = cnt > 0u ? cnt : 1u;
}
__device__ __forceinline__ void xcd_barrier(const XcdBarrier& b) {
    asm volatile("s_waitcnt vmcnt(0)" ::: "memory");
    __syncthreads();
    if (threadIdx.x == 0) {
        unsigned* bar = b.bar;
        __builtin_amdgcn_s_waitcnt(0);
        unsigned nloc = b.st[0], nx = b.st[1];
        if (nloc == 0u) { xcd_barrier_complete(bar, b.x, nloc, nx); b.st[0] = nloc; b.st[1] = nx; }
        const unsigned old = xb_add(&bar[XB_XSUB(b.x)], 1u);
        const unsigned gen = old / nloc;
        if (old + 1u == (gen + 1u) * nloc) {
            __builtin_amdgcn_fence(__ATOMIC_RELEASE, "agent");
            asm volatile("s_waitcnt vmcnt(0)" ::: "memory");
            const unsigned og = xb_add(&bar[XB_TOP], 1u);
            const unsigned tg = og / nx;
            if (og + 1u == (tg + 1u) * nx) xb_add(&bar[XB_TOPGEN], 1u);
            else XB_SPIN(xb_ld(&bar[XB_TOPGEN]) == tg, bar);
            __builtin_amdgcn_fence(__ATOMIC_ACQUIRE, "agent");
            xb_add(&bar[XB_XGEN(b.x)], 1u);
            asm volatile("s_waitcnt vmcnt(0)" ::: "memory");
        } else {
            XB_SPIN(xb_ld(&bar[XB_XGEN(b.x)]) == gen, bar);
            __builtin_amdgcn_fence(__ATOMIC_ACQUIRE, "agent");
            asm volatile("s_waitcnt vmcnt(0)" ::: "memory");
        }
    }
    __syncthreads();
}

struct Args { const float* in[21]; float* out; unsigned char* ws; int CH; int pad; };
constexpr int LDS_BYTES = 131072 + 1024;

__global__ void __launch_bounds__(NWAVES * 64, 2) mega_fwd(Args args) {
    extern __shared__ __attribute__((aligned(16))) unsigned char lds[];
    cg::grid_group grid = cg::this_grid();
    const int tid = threadIdx.x, lane = tid & 63, wave = __builtin_amdgcn_readfirstlane(tid >> 6);
    const int G = gridDim.x, bx = blockIdx.x;
    const int vcu = (G % 8 == 0) ? (bx % 8) * (G / 8) + bx / 8 : bx;
    unsigned char* ws = args.ws;
    float* lamv = (float*)(ws + WS_CTL);
    float* rope = (float*)(ws + WS_ROPE);
    bf16_t* Win_t = (bf16_t*)(ws + WS_WIN); bf16_t* Wmem_t = (bf16_t*)(ws + WS_WMEM); bf16_t* Wbr_t = (bf16_t*)(ws + WS_WBA);
    bf16_t* Wout_t = (bf16_t*)(ws + WS_WOUT);
    bf16_t* memb = (bf16_t*)(ws + WS_MEMB); bf16_t* kvm = (bf16_t*)(ws + WS_KVM); bf16_t* xb = (bf16_t*)(ws + WS_XB); bf16_t* Hc = (bf16_t*)(ws + WS_H);
    float* rstat = (float*)(ws + WS_H + (size_t)args.CH * INC * 2);
    float* X = args.out;
    const int CH = args.CH, nchunk = NTOK / CH;
    PG8_LAS unsigned char* lds3 = (PG8_LAS unsigned char*)lds;
    volatile LAS unsigned* MISC = (volatile LAS unsigned*)(lds3 + 131072);
    if (tid < 64) MISC[tid] = 0u;
    __syncthreads();
    const XcdBarrier xbar = xcd_barrier_post((unsigned*)(ws + WS_BAR), MISC + 8);
#define GRID_BAR() xcd_barrier(xbar)

    {
        for (int it = bx; it < 256; it += G) {
            const int L = it >> 6, g = (it >> 4) & 3, k0 = (it & 15) * 64;
            float* Wt = (float*)lds; float* Pw = Wt + 64 * 129;
            const float* wsrc = args.in[6] + ((size_t)L * DM + k0) * INC + g * 128;
            for (int e = tid; e < 64 * 128; e += 512) { const int r = e >> 7, c = e & 127; Wt[r * 129 + c] = wsrc[(size_t)r * INC + c]; }
            const float* psrc = args.in[8] + (size_t)(L * 4 + g) * 128 * 128;
            for (int e = tid; e < 128 * 128; e += 512) Pw[e] = psrc[e];
            __syncthreads();
            const int k = tid & 63, dg = tid >> 6;
            float acc[16];
#pragma unroll
            for (int j = 0; j < 16; ++j) acc[j] = 0.f;
            for (int c = 0; c < 128; ++c) { const float a = Wt[k * 129 + c];
#pragma unroll
                for (int j4 = 0; j4 < 4; ++j4) { const f32x4 p = *(const f32x4*)(Pw + c * 128 + dg * 16 + j4 * 4);
                    acc[j4 * 4 + 0] += a * p.x; acc[j4 * 4 + 1] += a * p.y; acc[j4 * 4 + 2] += a * p.z; acc[j4 * 4 + 3] += a * p.w; } }
            bf16_t* dst = Win_t + ((size_t)L * INC + g * 128 + dg * 16) * DM + k0 + k;
#pragma unroll
            for (int j = 0; j < 16; ++j) dst[(size_t)j * DM] = (bf16_t)(cvt_pk_bf16(acc[j], 0.f) & 0xffffu);
            __syncthreads();
        }
        const int gw = bx * NWAVES + wave, NGW = G * NWAVES;
        float* scr = (float*)(lds + wave * 16384);
        constexpr int I_IN = 16 * 272, I_SQ = 16 * 32, I_HF = 8 * 32, I_L = I_IN + 3 * I_SQ + 2 * I_HF;
        for (int it = gw; it < DEPTH * I_L; it += NGW) {
            const int L = it / I_L; int r = it % I_L;
            if (r < I_IN) { transpose_item(args.in[6] + (size_t)L * DM * INC, DM, INC, Win_t + (size_t)L * INC * DM, DM, scr, r / 272, 16 + r % 272, lane); continue; } r -= I_IN;
            if (r < I_SQ) { transpose_item(args.in[7] + (size_t)L * DM * DM, DM, DM, Wmem_t + (size_t)L * DM * DM, DM, scr, r / 32, r % 32, lane); continue; } r -= I_SQ;
            if (r < I_HF) { transpose_item(args.in[15] + (size_t)L * 512 * DM, 512, DM, Wbr_t + (size_t)L * DM * 2048, 2048, scr, r / 32, r % 32, lane); continue; } r -= I_HF;
            if (r < I_SQ) { transpose_item(args.in[16] + (size_t)L * DM * DM, DM, DM, Wbr_t + (size_t)L * DM * 2048 + 512, 2048, scr, r / 32, r % 32, lane); continue; } r -= I_SQ;
            if (r < I_HF) { transpose_item(args.in[17] + (size_t)L * 512 * DM, 512, DM, Wbr_t + (size_t)L * DM * 2048 + 1536, 2048, scr, r / 32, r % 32, lane); continue; } r -= I_HF;
            transpose_item(args.in[18] + (size_t)L * DM * DM, DM, DM, Wout_t + (size_t)L * DM * DM, DM, scr, r / 32, r % 32, lane);
        }
        for (int m = gw; m < MEMROWS; m += NGW) {
            const float* src = (m < 1024) ? args.in[2] + (size_t)m * DM : args.in[3] + (size_t)(m - 1024) * DM;
#pragma unroll
            for (int j = 0; j < 4; ++j) { const f32x4 v = ((const f32x4*)src)[lane + 64 * j]; u32x2 w; w.x = cvt_pk_bf16(v.x, v.y); w.y = cvt_pk_bf16(v.z, v.w); ((u32x2*)(memb + (size_t)m * DM))[lane + 64 * j] = w; }
        }
        for (int m = gw; m < NTOK; m += 2 * NGW) {
            const int m1 = m + NGW;
            const float* src = (m < NP) ? args.in[0] + (size_t)m * DM : args.in[1] + (size_t)(m - NP) * DM;
            if (m1 < NTOK) { const float* src1 = (m1 < NP) ? args.in[0] + (size_t)m1 * DM : args.in[1] + (size_t)(m1 - NP) * DM;
                ln_row2(src, src1, args.in[4], args.in[5], X + (size_t)m * DM, X + (size_t)m1 * DM, xb + (size_t)m * DM, xb + (size_t)m1 * DM, lane, rstat + 2 * (size_t)m, rstat + 2 * (size_t)m1, false); }
            else ln_row(src, args.in[4], args.in[5], X + (size_t)m * DM, xb + (size_t)m * DM, lane, rstat + 2 * (size_t)m, false);
        }
        for (int e = bx * 512 + tid; e < SP * 8; e += G * 512) {
            const int pos = e >> 3, j = e & 7;
            const double inv = (j == 0) ? 1.0 : (j == 1) ? 0.19392274474868576 : (j == 2) ? 0.03760603093086393 : (j == 3) ? 0.007292664737217109 :
                               (j == 4) ? 0.001414213562373095 : (j == 5) ? 0.0002742481756762073 : (j == 6) ? 5.318295896944988e-05 : 1.031338537721246e-05;
            double s, c; sincos_d((double)pos * inv, s, c);
            rope[pos * 16 + j] = (float)c; rope[pos * 16 + 8 + j] = (float)s;
        }
        if (bx == 0 && wave == 0) {
            for (int L = 0; L < DEPTH; ++L) {
                const float d1 = wave_sum(args.in[10][L * 64 + lane] * args.in[11][L * 64 + lane]);
                const float d2 = wave_sum(args.in[12][L * 64 + lane] * args.in[13][L * 64 + lane]);
                const float li = (L == 0) ? 0.20000000000000007f : (L == 1) ? 0.35550906759096934f : (L == 2) ? 0.4707130183435842f : 0.5560582041556406f;
                if (lane == 0) { lamv[L] = expf(d1) - expf(d2) + li; lamv[4 + L] = 1.f - li; }
            }
        }
    }
    grid.sync();
    {
        pg8::Gemm g{memb, Wmem_t, MEMROWS, 4096, DM, DM, DM}; pg8::StaticOrder S; S.init(MEMROWS, 4096, G, bx);
        pg8::EpiStore E{kvm, 4096};
        pg8::gemm_phase<pg8::EpiStore, pg8::StaticOrder, true, true>(lds3, g, S, E);
    }
    const int gw = bx * NWAVES + wave, NGW = G * NWAVES;
    for (int L = 0; L < DEPTH; ++L) {
        for (int c = 0; c < nchunk; ++c) {
            const int row0g = c * CH; const bool prompt = row0g < NP; const int S_ = prompt ? SP : SS;
            {
                pg8::Gemm g{xb + (size_t)row0g * DM, Win_t + (size_t)L * INC * DM, CH, INC, DM, DM, DM}; pg8::StaticOrder S; S.init(CH, INC, G, bx);
                pg8::EpiIn E{Hc, rope, row0g, S_ - 1};
                pg8::gemm_phase<pg8::EpiIn, pg8::StaticOrder, true, true>(lds3, g, S, E);
#if PROBE_P1X2
                pg8::gemm_phase<pg8::EpiIn, pg8::StaticOrder, true, true>(lds3, g, S, E);
#endif
            }
            GRID_BAR();
            {
                const float lam = lamv[L], oscale = lamv[4 + L];
                const int nqb = S_ / 128, nUA = (CH / 128) * 8;
                att::Pre pre = att::pre_zero(); bool have = false;
                for (int u = vcu; u < nUA; u += G) {
                    const int bh = u / nqb, qb = u % nqb, bl = bh >> 3, hd = bh & 7;
                    bf16_t* base = Hc + (size_t)(bl * S_) * INC + hd * 128;
                    const int un = u + G; const bool hn = un < nUA; const int u2 = hn ? un : u;
                    const int bh2 = u2 / nqb, qb2 = u2 % nqb;
                    const int kvo = ((bh2 >> 3) * S_) * INC + (bh2 & 7) * 128;
                    pre = att::attn_unit<0>(base + (size_t)(qb * 128) * INC + C_Q, base + C_K, base + C_V, base + (size_t)(qb * 128) * INC + C_AZ,
                                      S_, (char*)lds, args.in[14] + L * 128, lam, oscale,
                                      pre, have, Hc, hn ? kvo + (qb2 * 128) * INC + C_Q : -1, kvo);
                    have = hn;
                }
                const int nUC = (CH / 256) * 4;
                unsigned* qctr = (unsigned*)(ws + WS_BAR + 14336) + (L * nchunk + c) * 2;
                for (;;) { if (tid == 0) MISC[16] = __hip_atomic_fetch_add(qctr, 1u, __ATOMIC_RELAXED, __HIP_MEMORY_SCOPE_AGENT); __syncthreads(); const int u = (int)MISC[16]; __syncthreads(); if (u >= nUC) break;
                    const int rb = u >> 2, hd = u & 3; const int grow = row0g + rb * 256;
                    const int mb = (grow < NP) ? (grow / SP) : (4 + (grow - NP) / SS);
                    bf16_t* qp = Hc + (size_t)(rb * 256) * INC + hd * 128;
                    const bf16_t* kp = kvm + (size_t)(mb * 256) * 4096 + L * 1024 + hd * 128;
                    { att::Pre dummy = att::pre_zero(); (void)att::attn_unit<1>(qp + C_XQ, kp, kp + 512, qp + C_XZ, 256, (char*)lds, nullptr, 0.f, 0.f, dummy, false, nullptr, -1, 0); }
                }
                const int nUP = CH / 32;
                for (;;) { if (tid == 0) MISC[17] = __hip_atomic_fetch_add(qctr + 1, 1u, __ATOMIC_RELAXED, __HIP_MEMORY_SCOPE_AGENT); __syncthreads(); const int u = (int)MISC[17]; __syncthreads(); if (u >= nUP) break;
                    const int tidp = opaque_tid();
                    const int t0 = u * 32, s0 = (row0g + t0) & (S_ - 1);
                    const bf16_t* sq = Hc + (size_t)(t0 - s0) * INC;
                    unsigned* ubuf = (unsigned*)lds;
                    const int cp = tidp & 255, th = tidp >> 8, ch = cp * 2, half = 1 << (cp >> 6);
                    unsigned wz[16];
#pragma unroll
                    for (int i = 0; i < 16; ++i) wz[i] = *(const unsigned*)(sq + (size_t)(s0 + th * 16 + i) * INC + C_PZ + ch);
#pragma unroll 8
                    for (int it = 0; it < 24; ++it) { const int e = tidp + it * 512; const int r = e >> 8, cq = e & 255, sr_ = s0 - 8 + r;
                        if (e < 47 * 256 && sr_ >= 0 && sr_ < S_) ubuf[e] = *(const unsigned*)(sq + (size_t)sr_ * INC + 2 * cq); }
                    const float ps0 = args.in[9][L * 512 + ch], ps1 = args.in[9][L * 512 + ch + 1];
                    __syncthreads();
                    {
                        const int sf = s0 + th * 16;
                        int lo = sf - half; if (lo < 0) lo = 0;
                        int hi_ = sf + half - 1; if (hi_ > S_ - 1) hi_ = S_ - 1;
                        float a0 = 0.f, a1 = 0.f;
                        for (int r = lo; r <= hi_; ++r) { const unsigned w = ubuf[(r - s0 + 8) * 256 + cp]; a0 += bf_lo(w); a1 += bf_hi(w); }
#pragma unroll
                        for (int i = 0; i < 16; ++i) {
                            const int ti = th * 16 + i, s = sf + i;
                            const unsigned wu = ubuf[(ti + 8) * 256 + cp];
                            const float rc = __builtin_amdgcn_rcpf((float)(hi_ - lo + 1));
                            const float d0 = a0 * rc - bf_lo(wu), d1 = a1 * rc - bf_hi(wu);
                            const float z0 = bf_lo(wz[i]), z1 = bf_hi(wz[i]);
                            const float y0 = d0 * ps0 * z0 * sigmoidf_(z0), y1 = d1 * ps1 * z1 * sigmoidf_(z1);
                            *(unsigned*)(Hc + (size_t)(t0 + ti) * INC + C_PZ + ch) = cvt_pk_bf16(y0, y1);
                            const int nlo = (s + 1 - half) < 0 ? 0 : (s + 1 - half);
                            const int nhi = (s + half) > (S_ - 1) ? (S_ - 1) : (s + half);
                            if (nhi > hi_) { const unsigned w = ubuf[(nhi - s0 + 8) * 256 + cp]; a0 += bf_lo(w); a1 += bf_hi(w); }
                            if (nlo > lo) { const unsigned w = ubuf[(lo - s0 + 8) * 256 + cp]; a0 -= bf_lo(w); a1 -= bf_hi(w); }
                            lo = nlo; hi_ = nhi;
                        }
                    }
                    __syncthreads();
                }
            }
            GRID_BAR();
            {
                pg8::Order3 S; S.base.init(CH, DM, G, bx);
                pg8::Gemm g{Hc, Wbr_t + (size_t)L * DM * 2048, CH, DM, DM, INC, 2048};
                pg8::EpiBr3 E{Hc};
                pg8::gemm_phase<pg8::EpiBr3, pg8::Order3, true, true>(lds3, g, S, E);
            }
            GRID_BAR();
            {
                pg8::Gemm g{Hc + C_AZ, Wout_t + (size_t)L * DM * DM, CH, DM, DM, INC, DM}; pg8::StaticOrder S; S.init(CH, DM, G, bx);
                const float* yin = (L > 0) ? X + (size_t)row0g * DM : (row0g < NP ? args.in[0] + (size_t)row0g * DM : args.in[1] + (size_t)(row0g - NP) * DM);
                pg8::EpiOut E{yin, X + (size_t)row0g * DM, rstat + 2 * (size_t)row0g, (L > 0) ? args.in[19] + (L - 1) * DM : args.in[4], (L > 0) ? args.in[20] + (L - 1) * DM : args.in[5]};
                pg8::gemm_phase<pg8::EpiOut, pg8::StaticOrder, true, true>(lds3, g, S, E);
            }
            GRID_BAR();
            { const int lane5 = opaque_tid() & 63;
              for (int m = row0g + gw; m < row0g + CH; m += 2 * NGW) {
                const int m1 = m + NGW;
                if (m1 < row0g + CH) ln_row2(X + (size_t)m * DM, X + (size_t)m1 * DM, args.in[19] + L * DM, args.in[20] + L * DM, X + (size_t)m * DM, X + (size_t)m1 * DM, xb + (size_t)m * DM, xb + (size_t)m1 * DM, lane5, rstat + 2 * (size_t)m, rstat + 2 * (size_t)m1, L == DEPTH - 1);
                else ln_row(X + (size_t)m * DM, args.in[19] + L * DM, args.in[20] + L * DM, X + (size_t)m * DM, xb + (size_t)m * DM, lane5, rstat + 2 * (size_t)m, L == DEPTH - 1); } }
#if PROBE_SYNC
            for (int q = 0; q < 20; ++q) grid.sync();
#endif
        }
    }
}

extern "C" void kernel_launch(void* const* d_in, const int* in_sizes, int n_in, void* d_out, int out_size, void* d_ws, size_t ws_size, hipStream_t stream) {
    static int grid = 0;
    if (grid == 0) {
        int dev = 0, cus = 0, per_cu = 0;
        if (hipGetDevice(&dev) != hipSuccess || hipDeviceGetAttribute(&cus, hipDeviceAttributeMultiprocessorCount, dev) != hipSuccess) { fprintf(stderr, "kernel_launch: device query failed\n"); grid = -1; return; }
        if (hipFuncSetAttribute((const void*)mega_fwd, hipFuncAttributeMaxDynamicSharedMemorySize, LDS_BYTES) != hipSuccess) { fprintf(stderr, "kernel_launch: hipFuncSetAttribute failed\n"); grid = -1; return; }
        if (hipOccupancyMaxActiveBlocksPerMultiprocessor(&per_cu, (const void*)mega_fwd, NWAVES * 64, LDS_BYTES) != hipSuccess || per_cu < 1) { fprintf(stderr, "kernel_launch: occupancy query failed (%d)\n", per_cu); (void)hipGetLastError(); per_cu = 1; }
        grid = cus * per_cu;
    }
    if (grid < 0) return;
    Args a{};
    for (int i = 0; i < 21; ++i) a.in[i] = (const float*)d_in[i];
    a.out = (float*)d_out; a.ws = (unsigned char*)d_ws;
    int CH = 32768;
    while (CH > 8192 && WS_H + (size_t)CH * INC * 2 + (size_t)NTOK * 8 > ws_size) CH >>= 1;
    if (WS_H + (size_t)CH * INC * 2 + (size_t)NTOK * 8 > ws_size) { fprintf(stderr, "kernel_launch: workspace too small (%zu)\n", ws_size); return; }
    a.CH = CH; a.pad = 0;
    if (hipMemsetAsync((char*)d_ws + WS_BAR, 0, BAR_BYTES, stream) != hipSuccess) { fprintf(stderr, "kernel_launch: memset failed\n"); return; }
    void* kargs[] = {&a};
    hipError_t e = hipLaunchCooperativeKernel((const void*)mega_fwd, dim3(grid), dim3(NWAVES * 64), kargs, LDS_BYTES, stream);
    if (e != hipSuccess) fprintf(stderr, "kernel_launch: cooperative launch failed: %s (grid %d)\n", hipGetErrorString(e), grid);
}
```
